# Optimizing an MI355X kernel written in HIP

```python
import jax, jax.numpy as jnp
from jax import lax
import numpy as np

D_MODEL = 1024
BATCH = 4
SEQ = 8192
DEPTH = 2

HEAD_DIM = 64
POOL_WIDTH = D_MODEL // 4
POOL_WINDOWS = (2, 4, 8, 16)
N_POOL_GROUPS = len(POOL_WINDOWS)
POOL_GC = POOL_WIDTH // N_POOL_GROUPS
ATTN_WIDTH = D_MODEL - POOL_WIDTH
N_ATTN_HEADS = ATTN_WIDTH // HEAD_DIM
DIL_PATTERNS = ((128, 1), (512, 4), (2048, 16))
HEADS_PER_PATTERN = N_ATTN_HEADS // len(DIL_PATTERNS)
ROT_DIM = HEAD_DIM // 4
ROPE_THETA = 500000.0
BLK = 128
D_FF = 4 * D_MODEL
PLE_DIM = 256
EPS = 1e-6

kernel_name = "hybrid_pool_dilated_attn_block"


def rmsnorm(x, g):
    xf = x.astype(jnp.float32)
    y = xf * lax.rsqrt(jnp.mean(xf * xf, axis=-1, keepdims=True) + EPS)
    return (y * g.astype(jnp.float32)).astype(x.dtype)


def rotary_tables(positions, dtype):
    inv_freq = ROPE_THETA ** (-jnp.arange(0, ROT_DIM, 2, dtype=jnp.float32) / ROT_DIM)
    ang = positions.astype(jnp.float32)[..., None] * inv_freq
    return jnp.cos(ang)[:, :, None, :].astype(dtype), jnp.sin(ang)[:, :, None, :].astype(dtype)


def apply_partial_rotary(x, cos, sin):
    half = ROT_DIM // 2
    x1 = x[..., :half]
    x2 = x[..., half:ROT_DIM]
    rot = jnp.concatenate([x1 * cos - x2 * sin, x2 * cos + x1 * sin], axis=-1)
    return jnp.concatenate([rot, x[..., ROT_DIM:]], axis=-1)


def pool_mixer(u, w, scale):
    B, S, _ = u.shape
    ug = u.reshape(B, S, N_POOL_GROUPS, POOL_GC).astype(jnp.float32)
    c = lax.cumsum(ug, axis=1)
    c0 = jnp.pad(c, ((0, 0), (1, 0), (0, 0), (0, 0)))
    t = jnp.arange(S, dtype=jnp.int32)
    win = jnp.array(POOL_WINDOWS, dtype=jnp.int32)
    lo = jnp.maximum(t[:, None] + 1 - win[None, :], 0)
    c_lo = jnp.take_along_axis(c0, lo[None, :, :, None], axis=1)
    cnt = (t[:, None] + 1 - lo).astype(jnp.float32)
    y = ((c - c_lo) / cnt[None, :, :, None] - ug).astype(u.dtype)
    y = jnp.einsum('bsgc,gcd->bsgd', y, w).reshape(B, S, POOL_WIDTH)
    return y * scale


def dilated_window_attention(q, k, v, window, dil):
    B, S, H, Dh = q.shape
    steps = window // dil
    L = -(-S // (dil * BLK)) * BLK
    pad = L * dil - S
    nb = L // BLK

    def to_strided(a):
        a = jnp.pad(a, ((0, 0), (0, pad), (0, 0), (0, 0)))
        a = a.reshape(B, L, dil, H, Dh).transpose(0, 2, 1, 3, 4)
        return a.reshape(B, dil, nb, BLK, H, Dh)

    def with_prev(a):
        prev = jnp.pad(a[:, :, :-1], ((0, 0), (0, 0), (1, 0), (0, 0), (0, 0), (0, 0)))
        return jnp.concatenate([prev, a], axis=3)

    qs = to_strided(q)
    kb = with_prev(to_strided(k))
    vb = with_prev(to_strided(v))
    s = jnp.einsum('brnqhd,brnkhd->brnhqk', qs, kb,
                   preferred_element_type=jnp.float32) * (HEAD_DIM ** -0.5)
    qi = jnp.arange(nb)[:, None] * BLK + jnp.arange(BLK)[None, :]
    ki = jnp.arange(nb)[:, None] * BLK - BLK + jnp.arange(2 * BLK)[None, :]
    dist = qi[:, :, None] - ki[:, None, :]
    valid = (dist >= 0) & (dist <= steps) & (ki[:, None, :] >= 0)
    s = jnp.where(valid[None, None, :, None], s, -jnp.inf)
    m = jnp.max(s, axis=-1, keepdims=True)
    e = jnp.exp(s - m)
    l = jnp.sum(e, axis=-1, keepdims=True)
    o = jnp.einsum('brnhqk,brnkhd->brnqhd', e / l, vb.astype(jnp.float32))
    lse = (m + jnp.log(l))[..., 0]
    o = o.reshape(B, dil, L, H, Dh).transpose(0, 2, 1, 3, 4).reshape(B, L * dil, H, Dh)[:, :S]
    lse = lse.transpose(0, 1, 2, 4, 3).reshape(B, dil, L, H).transpose(0, 2, 1, 3)
    lse = lse.reshape(B, L * dil, H)[:, :S]
    return o, lse


def dilated_mixer(q, k, v):
    outs, lses = [], []
    for g, (window, dil) in enumerate(DIL_PATTERNS):
        sl = slice(g * HEADS_PER_PATTERN, (g + 1) * HEADS_PER_PATTERN)
        o, lse = dilated_window_attention(q[:, :, sl], k[:, :, sl], v[:, :, sl], window, dil)
        outs.append(o)
        lses.append(lse)
    wts = jax.nn.softmax(jnp.stack(lses, axis=0), axis=0)
    o = jnp.concatenate([outs[g] * wts[g][..., None] for g in range(len(DIL_PATTERNS))], axis=2)
    B, S = q.shape[0], q.shape[1]
    return o.reshape(B, S, ATTN_WIDTH).astype(q.dtype)


def setup_inputs(seed: int = 0) -> dict:
    key = jax.random.key(seed)
    ks = jax.random.split(key, 16)
    f32 = jnp.float32
    n_in = POOL_WIDTH + 3 * ATTN_WIDTH
    return {
        "x": jax.random.normal(ks[0], (BATCH, SEQ, D_MODEL), f32),
        "p": jax.random.normal(ks[1], (DEPTH, BATCH, SEQ, PLE_DIM), f32),
        "positions": jnp.broadcast_to(jnp.arange(SEQ, dtype=jnp.int32), (BATCH, SEQ)),
        "norm1": 1.0 + 0.02 * jax.random.normal(ks[2], (DEPTH, D_MODEL), f32),
        "w_in": jax.random.normal(ks[3], (DEPTH, D_MODEL, n_in), f32) * D_MODEL ** -0.5,
        "pool_w": jax.random.normal(ks[4], (DEPTH, N_POOL_GROUPS, POOL_GC, POOL_GC), f32) * POOL_GC ** -0.5,
        "pool_scale": 1.0 + 0.02 * jax.random.normal(ks[5], (DEPTH, POOL_WIDTH), f32),
        "w_out": jax.random.normal(ks[6], (DEPTH, POOL_WIDTH + ATTN_WIDTH, D_MODEL), f32) * (POOL_WIDTH + ATTN_WIDTH) ** -0.5,
        "norm2": 1.0 + 0.02 * jax.random.normal(ks[7], (DEPTH, D_MODEL), f32),
        "w_up": jax.random.normal(ks[8], (DEPTH, D_MODEL, D_FF), f32) * D_MODEL ** -0.5,
        "w_down": jax.random.normal(ks[9], (DEPTH, D_FF, D_MODEL), f32) * D_FF ** -0.5,
        "norm3": 1.0 + 0.02 * jax.random.normal(ks[10], (DEPTH, D_MODEL), f32),
        "w_gate": jax.random.normal(ks[11], (DEPTH, D_MODEL, D_MODEL), f32) * D_MODEL ** -0.5,
        "w_ple": jax.random.normal(ks[12], (DEPTH, PLE_DIM, D_MODEL), f32) * PLE_DIM ** -0.5,
        "final_norm": 1.0 + 0.02 * jax.random.normal(ks[13], (D_MODEL,), f32),
    }


def reference(x, p, positions, norm1, w_in, pool_w, pool_scale, w_out, norm2, w_up, w_down,
              norm3, w_gate, w_ple, final_norm):
    B, S, _ = x.shape
    cos, sin = rotary_tables(positions, x.dtype)
    h = x
    for i in range(DEPTH):
        hn = rmsnorm(h, norm1[i])
        z = hn @ w_in[i]
        u = z[..., :POOL_WIDTH]
        q, k, v = jnp.split(z[..., POOL_WIDTH:], 3, axis=-1)
        q = apply_partial_rotary(q.reshape(B, S, N_ATTN_HEADS, HEAD_DIM), cos, sin)
        k = apply_partial_rotary(k.reshape(B, S, N_ATTN_HEADS, HEAD_DIM), cos, sin)
        v = v.reshape(B, S, N_ATTN_HEADS, HEAD_DIM)
        pool_out = pool_mixer(u, pool_w[i], pool_scale[i])
        attn_out = dilated_mixer(q, k, v)
        h = h + jnp.concatenate([pool_out, attn_out], axis=-1) @ w_out[i]
        hn = rmsnorm(h, norm2[i])
        h = h + jnp.square(jax.nn.relu(hn @ w_up[i])) @ w_down[i]
        gate = jax.nn.sigmoid(rmsnorm(h, norm3[i]) @ w_gate[i])
        h = h + gate * (p[i] @ w_ple[i])
    return rmsnorm(h, final_norm)
```

```cpp
#include <hip/hip_runtime.h>
#include <hip/hip_cooperative_groups.h>
#include <cstdio>
#include <cstdint>
namespace cg = cooperative_groups;

#define LAS __attribute__((address_space(3)))
typedef unsigned short bf16_t;
typedef short bf16x8 __attribute__((ext_vector_type(8)));
typedef float f32x4 __attribute__((ext_vector_type(4)));
typedef float f32x16 __attribute__((ext_vector_type(16)));
typedef unsigned u32x4 __attribute__((ext_vector_type(4)));
typedef unsigned u32x2 __attribute__((ext_vector_type(2)));

constexpr int BATCH = 4, SEQ = 8192, DM = 1024, T = BATCH * SEQ, NIN = 2560, FF = 4096, PLE = 256, DEPTH = 2, NH = 12;
constexpr float EPS = 1e-6f;
constexpr int NWAVES = 8, NTHREADS = 512;
constexpr int LDS_BYTES = 135168;

constexpr size_t MiB = 1u << 20;
constexpr size_t WS_ROT = 0;
constexpr size_t WS_SSP = 2 * MiB;
constexpr size_t SSP_STRIDE = 2 * MiB;
constexpr size_t WS_POOLW = 16 * MiB;
constexpr size_t WS_BAR = 16 * MiB + 512 * 1024;
constexpr size_t WS_W = 17 * MiB;
constexpr size_t W_LAYER = 26 * MiB, W_IN = 0, W_OUT = 5 * MiB, W_UP = 7 * MiB, W_DOWN = 15 * MiB, W_GATE = 23 * MiB, W_PLE = 25 * MiB;
constexpr size_t WS_HB = 69 * MiB;
constexpr size_t WS_PB = 133 * MiB;
constexpr size_t WS_E = 165 * MiB;
constexpr size_t WS_BIG = 229 * MiB;
constexpr size_t BIG_U = 0, BIG_Q = 16 * MiB, BIG_K = 64 * MiB, BIG_VT = 112 * MiB, BIG_MIX = 160 * MiB;
constexpr size_t WS_END = 485 * MiB;

__device__ __forceinline__ unsigned cvt_pk_bf16(float lo, float hi) { unsigned r; asm volatile("v_cvt_pk_bf16_f32 %0, %1, %2" : "=v"(r) : "v"(lo), "v"(hi)); return r; }
__device__ __forceinline__ u32x4 pack8(f32x4 a, f32x4 b) { u32x4 w; w.x = cvt_pk_bf16(a[0], a[1]); w.y = cvt_pk_bf16(a[2], a[3]); w.z = cvt_pk_bf16(b[0], b[1]); w.w = cvt_pk_bf16(b[2], b[3]); return w; }
__device__ __forceinline__ float bf_lo(unsigned w) { return __uint_as_float(w << 16); }
__device__ __forceinline__ float bf_hi(unsigned w) { return __uint_as_float(w & 0xffff0000u); }
__device__ __forceinline__ float shx(float v, int mask, int lane) { return __int_as_float(__builtin_amdgcn_ds_bpermute((lane ^ mask) << 2, __float_as_int(v))); }
__device__ __forceinline__ float wave_sum(float v, int lane) {
#pragma unroll
    for (int o = 1; o < 64; o <<= 1) v += shx(v, o, lane);
    return v;
}
__device__ __forceinline__ float row_rs(const float* ssp, int row) {
    const f32x4* p = (const f32x4*)(ssp + (size_t)row * 16);
    const f32x4 a = p[0], b = p[1], c = p[2], d = p[3];
    const float s = ((a[0] + a[1]) + (a[2] + a[3])) + ((b[0] + b[1]) + (b[2] + b[3])) + ((c[0] + c[1]) + (c[2] + c[3])) + ((d[0] + d[1]) + (d[2] + d[3]));
    return __builtin_amdgcn_rsqf(s * (1.0f / DM) + EPS);
}

__device__ __forceinline__ int lane_now() { unsigned z = 0u; asm volatile("" : "+v"(z)); return (int)__builtin_amdgcn_mbcnt_hi(~0u, __builtin_amdgcn_mbcnt_lo(~0u, z)); }

namespace pg8 {
constexpr int BM = 256, BK = 64, HALF = 128, HTB = HALF * BK * 2, STAGE_BYTES = 8 * HTB;
__host__ __device__ __forceinline__ int lds_byte(int r, int c) { const int st = (r >> 4) * 2 + (c >> 5), rr = r & 15, cc = c & 31, ob = rr * 64 + cc * 2; return st * 1024 + (ob ^ (((ob >> 9) & 1) << 5)); }
__host__ __device__ __forceinline__ void stage_rc(int b, int& R, int& C) { const int st = b / 1024, sb = b % 1024, swz = sb ^ (((sb >> 9) & 1) << 5); R = (st >> 1) * 16 + swz / 64; C = (st & 1) * 32 + (swz % 64) / 2; }
__host__ __device__ __forceinline__ int perm32(int rho) { const int n = rho >> 4, i = rho & 15; return 8 * (i >> 2) + 4 * n + (i & 3); }

struct Unit { int pm, pn, kind; };
__device__ __forceinline__ int remap8(int L, int n) { return (L % 8) * (n / 8) + L / 8; }

struct SchedStd {
    int nM, nN, nwg, G, c; const char* A; const char* B; size_t tstep;
    __device__ __forceinline__ void init(const bf16_t* A_, const bf16_t* B_, int M, int N, int K, int G_, int c_) { nM = M / BM; nN = N / BM; nwg = nM * nN; G = G_; c = c_; A = (const char*)A_; B = (const char*)B_; tstep = (size_t)BM * K * 2; }
    __device__ __forceinline__ bool next(int i, Unit& u) const {
        const int L = i * G + c; if (L >= nwg) return false;
        const int w = (nwg % 8 == 0) ? remap8(L, nwg) : L;
        const int nig = 8 * nN, gid = w / nig, fm = gid * 8, gsz = (nM - fm) < 8 ? (nM - fm) : 8;
        u.pm = fm + ((w % nig) % gsz); u.pn = (w % nig) / gsz; u.kind = 0; return true;
    }
    __device__ __forceinline__ void ptrs(const Unit& u, const char*& a, const char*& b) const { a = A + (size_t)u.pm * tstep; b = B + (size_t)u.pn * tstep; }
    __device__ __forceinline__ int bmap(const Unit&, int rb) const { return ((rb >> 5) << 6) + (rb & 31); }
    __device__ __forceinline__ int bhalf_rows() const { return 32; }
};
struct SchedIn {
    int G, c; const char* H; const char* W; size_t tstep;
    __device__ __forceinline__ void init(const bf16_t* H_, const bf16_t* W_, int G_, int c_) { G = G_; c = c_; H = (const char*)H_; W = (const char*)W_; tstep = (size_t)BM * DM * 2; }
    __device__ __forceinline__ bool next(int i, Unit& u) const {
        const int L = i * G + c; if (L >= 1280) return false;
        if (L < 896) { const int w = remap8(L, 896); u.pm = (w / 56) * 8 + ((w % 56) % 8); u.pn = (w % 56) / 8; u.kind = 0; }
        else { const int v = remap8(L - 896, 384); u.pn = v / 3; u.pm = v % 3; u.kind = 1; }
        return true;
    }
    __device__ __forceinline__ void ptrs(const Unit& u, const char*& a, const char*& b) const {
        if (u.kind == 0) { a = H + (size_t)u.pm * tstep; b = W + (size_t)u.pn * tstep; }
        else { a = W + (size_t)(7 + u.pm) * tstep; b = H + (size_t)u.pn * tstep; }
    }
    __device__ __forceinline__ int bmap(const Unit& u, int rb) const {
        if (u.kind == 0) return rb;
        const int sh = 2 * u.pm, per = 128 >> sh;
        return ((rb & (per - 1)) << sh) + (rb >> (7 - sh));
    }
    __device__ __forceinline__ int bhalf_rows() const { return 128; }
};

template <class Epi, class Sched>
__device__ __forceinline__ void gemm_phase(LAS unsigned char* lds, const int wid_in, const int K, const Sched& S, const Epi& E) {
    const int wid = __builtin_amdgcn_readfirstlane(wid_in), lane = lane_now(), tid = wid * 64 + lane, wr = wid >> 2, wc = wid & 3, fr = lane & 15, fq = lane >> 4;
    const int nt = K / BK;
    unsigned voffA[2], voffB[2];
    const size_t kstep = (size_t)(BK * 2);
    const size_t hstep = (size_t)HALF * K * 2;
    const size_t hstepB = (size_t)S.bhalf_rows() * K * 2;
    const unsigned ldsw = (unsigned)wid * 1024u;
    const int aoff = lds_byte(wr * 64 + fr, fq * 8), boff = lds_byte(wc * 32 + fr, fq * 8);
#define PG8_SA(b, h) (((b) * 2 + (h)) * HTB)
#define PG8_SB(b, h) ((4 + (b) * 2 + (h)) * HTB)
#define PG8_STAGE(bufoff, gbase, voff) do { _Pragma("unroll") for (int _i = 0; _i < 2; ++_i) \
        __builtin_amdgcn_global_load_lds((const unsigned*)((const char*)(gbase) + (voff)[_i]), (LAS unsigned*)(lds + (bufoff) + ldsw + _i * 8192), 16, 0, 0); } while (0)
#define PG8_LDA(dst, b, h) do { _Pragma("unroll") for (int m = 0; m < 4; ++m) _Pragma("unroll") for (int k = 0; k < 2; ++k) dst[m][k] = *(const LAS bf16x8*)(lds + PG8_SA(b, h) + aoff + m * 2048 + k * 1024); } while (0)
#define PG8_LDB(dst, b, h) do { _Pragma("unroll") for (int n = 0; n < 2; ++n) _Pragma("unroll") for (int k = 0; k < 2; ++k) dst[n][k] = *(const LAS bf16x8*)(lds + PG8_SB(b, h) + boff + n * 2048 + k * 1024); } while (0)
#define PG8_MMA(ai, bj, At, Bt) do { __builtin_amdgcn_s_setprio(1); _Pragma("unroll") for (int m = 0; m < 4; ++m) _Pragma("unroll") for (int n = 0; n < 2; ++n) _Pragma("unroll") for (int k = 0; k < 2; ++k) \
        acc[ai][bj][m][n] = __builtin_amdgcn_mfma_f32_16x16x32_bf16(Bt[n][k], At[m][k], acc[ai][bj][m][n], 0, 0, 0); __builtin_amdgcn_s_setprio(0); } while (0)
#define PG8_WAIT_V(n) asm volatile("s_waitcnt vmcnt(" #n ")" ::: "memory")
#define PG8_WAIT_L(n) asm volatile("s_waitcnt lgkmcnt(" #n ")" ::: "memory")
#define PG8_BAR __builtin_amdgcn_s_barrier()
#define PG8_SCHED __builtin_amdgcn_sched_barrier(0)
#define PG8_VOFFB(dst, un) do { const int tid_ = wid * 64 + lane_now(); _Pragma("unroll") for (int _i = 0; _i < 2; ++_i) { int R_, C_; stage_rc(tid_ * 16 + _i * 8192, R_, C_); const int Rb_ = (R_ & ~31) + perm32(R_ & 31); dst[_i] = (unsigned)(S.bmap(un, Rb_) * K + C_) * 2u; } } while (0)
    Unit cur, nxt; int ui = 0;
    if (!S.next(0, cur)) return;
#pragma unroll
    for (int i = 0; i < 2; ++i) { int R, C; stage_rc(tid * 16 + i * 8192, R, C); voffA[i] = (unsigned)(R * K + C) * 2u; }
    PG8_VOFFB(voffB, cur);
    f32x4 acc[2][2][4][2];
#pragma unroll
    for (int a = 0; a < 2; ++a)
#pragma unroll
        for (int b = 0; b < 2; ++b)
#pragma unroll
            for (int m = 0; m < 4; ++m)
#pragma unroll
                for (int n = 0; n < 2; ++n) acc[a][b][m][n] = (f32x4){0.f, 0.f, 0.f, 0.f};
    bf16x8 At[4][2], B0[2][2], B1[2][2];
    const char* cA; const char* cB; S.ptrs(cur, cA, cB);
    PG8_STAGE(PG8_SB(0, 0), cB, voffB); PG8_STAGE(PG8_SB(0, 1), cB + hstepB, voffB); PG8_STAGE(PG8_SA(0, 0), cA, voffA); PG8_STAGE(PG8_SA(0, 1), cA + hstep, voffA);
    E.prep(cur, (LAS float*)(lds + STAGE_BYTES), tid);
    if (wr == 1) PG8_BAR;
    PG8_WAIT_V(2); PG8_BAR;
    PG8_STAGE(PG8_SB(1, 0), cB + kstep, voffB); PG8_STAGE(PG8_SA(1, 0), cA + kstep, voffA); PG8_STAGE(PG8_SB(1, 1), cB + hstepB + kstep, voffB);
    PG8_WAIT_V(6); PG8_BAR;
    for (;;) {
        const bool has_next = S.next(ui + 1, nxt);
        const char* nA = cA; const char* nB = cB;
        if (has_next) S.ptrs(nxt, nA, nB);
        unsigned vb[2]; vb[0] = voffB[0]; vb[1] = voffB[1];
        _Pragma("unroll 1") for (int t = 0; t < nt; t += 2) {
            const bool last = (t == nt - 2);
            const char* a1 = cA + (size_t)(t + 1) * kstep;
            const char* a2 = last ? nA : cA + (size_t)(t + 2) * kstep; const char* b2 = last ? nB : cB + (size_t)(t + 2) * kstep;
            const char* a3 = a2 + kstep; const char* b3 = b2 + kstep;
            if (last && has_next) PG8_VOFFB(vb, nxt);
            PG8_LDB(B0, 0, 0); PG8_LDB(B1, 0, 1); PG8_SCHED; PG8_LDA(At, 0, 0); PG8_STAGE(PG8_SA(1, 1), a1 + hstep, voffA);
            PG8_WAIT_V(8); PG8_WAIT_L(0); PG8_BAR; PG8_MMA(0, 0, At, B0); PG8_MMA(0, 1, At, B1); PG8_BAR; PG8_SCHED;
            PG8_LDA(At, 0, 1); PG8_STAGE(PG8_SB(0, 0), b2, vb); PG8_STAGE(PG8_SB(0, 1), b2 + hstepB, vb); PG8_STAGE(PG8_SA(0, 0), a2, voffA);
            PG8_WAIT_V(8); PG8_WAIT_L(0); PG8_BAR; PG8_MMA(1, 0, At, B0); PG8_MMA(1, 1, At, B1); PG8_BAR; PG8_SCHED;
            PG8_LDB(B0, 1, 0); PG8_LDB(B1, 1, 1); PG8_SCHED; PG8_LDA(At, 1, 0); PG8_STAGE(PG8_SA(0, 1), a2 + hstep, voffA);
            PG8_WAIT_V(8); PG8_WAIT_L(0); PG8_BAR; PG8_MMA(0, 0, At, B0); PG8_MMA(0, 1, At, B1); PG8_BAR; PG8_SCHED;
            PG8_LDA(At, 1, 1); PG8_STAGE(PG8_SB(1, 0), b3, vb); PG8_STAGE(PG8_SB(1, 1), b3 + hstepB, vb); PG8_STAGE(PG8_SA(1, 0), a3, voffA);
            PG8_WAIT_V(8); PG8_WAIT_L(0); PG8_BAR; PG8_MMA(1, 0, At, B0); PG8_MMA(1, 1, At, B1); PG8_BAR; PG8_SCHED;
        }
        if (wr == 0) PG8_BAR;
        f32x4 pf[4];
        if (Epi::HAS_RS && has_next && wid < 4) { const f32x4* p_ = (const f32x4*)(E.ssp + (size_t)(E.rs_row(nxt) + wid * 64 + lane_now()) * 16); pf[0] = p_[0]; pf[1] = p_[1]; pf[2] = p_[2]; pf[3] = p_[3]; }
        else { pf[0] = pf[1] = pf[2] = pf[3] = (f32x4){1.f, 1.f, 1.f, 1.f}; }
        PG8_SCHED;
        { const int ln_e = lane_now(); int fr_e = ln_e & 15, fq_e = ln_e >> 4; asm volatile("" : "+v"(fr_e), "+v"(fq_e));
          E(acc, cur, wr, wc, fr_e, fq_e, (const LAS float*)(lds + STAGE_BYTES + (ui & 1) * 1024)); }
        if (!has_next) break;
        if (Epi::HAS_RS && wid < 4) { const f32x4 a_ = pf[0], b_ = pf[1], c_ = pf[2], d_ = pf[3];
            const float s_ = ((a_[0] + a_[1]) + (a_[2] + a_[3])) + ((b_[0] + b_[1]) + (b_[2] + b_[3])) + ((c_[0] + c_[1]) + (c_[2] + c_[3])) + ((d_[0] + d_[1]) + (d_[2] + d_[3]));
            int t2_ = wid * 64 + lane_now(); asm volatile("" : "+v"(t2_));
            ((LAS float*)(lds + STAGE_BYTES + ((ui + 1) & 1) * 1024))[t2_] = __builtin_amdgcn_rsqf(s_ * (1.0f / DM) + EPS); }
#pragma unroll
        for (int a = 0; a < 2; ++a)
#pragma unroll
            for (int b = 0; b < 2; ++b)
#pragma unroll
                for (int m = 0; m < 4; ++m)
#pragma unroll
                    for (int n = 0; n < 2; ++n) acc[a][b][m][n] = (f32x4){0.f, 0.f, 0.f, 0.f};
        cur = nxt; cA = nA; cB = nB; voffB[0] = vb[0]; voffB[1] = vb[1]; ++ui;
        if (wr == 1) PG8_BAR;
    }
    PG8_WAIT_V(0);
    PG8_BAR;
#undef PG8_SA
#undef PG8_SB
#undef PG8_STAGE
#undef PG8_LDA
#undef PG8_LDB
#undef PG8_MMA
#undef PG8_WAIT_V
#undef PG8_WAIT_L
#undef PG8_BAR
#undef PG8_SCHED
#undef PG8_VOFFB
}

typedef f32x4 Acc[2][2][4][2];
__device__ __forceinline__ u32x4 xchg8(u32x4 v) { u32x4 r;
#pragma unroll
    for (int e = 0; e < 4; ++e) r[e] = (unsigned)__builtin_amdgcn_update_dpp(0, (int)v[e], 0x128, 0xf, 0xf, false);
    return r; }
#define FULL_LINE_STORE(ptr_, ld_, rowbase_, colbase_, o0_, o1_) do { u32x4 dA_, dB_; \
        _Pragma("unroll") for (int e_ = 0; e_ < 4; ++e_) { dA_[e_] = (unsigned)__builtin_amdgcn_update_dpp((int)(o0_)[e_], (int)(o1_)[e_], 0x128, 0xf, 0xc, false); \
                                                          dB_[e_] = (unsigned)__builtin_amdgcn_update_dpp((int)(o1_)[e_], (int)(o0_)[e_], 0x128, 0xf, 0x3, false); } \
        bf16_t* p_ = (ptr_) + (size_t)((rowbase_) + (fr & 7)) * (ld_) + (colbase_) + (fr >> 3) * 32; \
        *(u32x4*)p_ = dA_; *(u32x4*)(p_ + (size_t)8 * (ld_)) = dB_; } while (0)

struct EpiIn {
    const float* ssp; unsigned char* ws;
    static constexpr bool HAS_RS = true;
    __device__ __forceinline__ int rs_row(const Unit& u) const { return (u.kind == 0 ? u.pm : u.pn) * BM; }
    __device__ __forceinline__ void prep(const Unit& u, LAS float* rsl, int tid) const { if (tid < 256) rsl[tid] = row_rs(ssp, rs_row(u) + tid); }
    __device__ __forceinline__ void operator()(const Acc& acc, const Unit& u, int wr, int wc, int fr, int fq, const LAS float* rsl) const {
        const float* rot = (const float*)(ws + WS_ROT); bf16_t* U = (bf16_t*)(ws + WS_BIG + BIG_U); bf16_t* Q = (bf16_t*)(ws + WS_BIG + BIG_Q); bf16_t* Kb = (bf16_t*)(ws + WS_BIG + BIG_K); bf16_t* VT = (bf16_t*)(ws + WS_BIG + BIG_VT);
        if (u.kind == 0) {
            const int pn = u.pn;
#pragma unroll
            for (int ai = 0; ai < 2; ++ai)
#pragma unroll
                for (int m = 0; m < 4; ++m) {
                    const int row = u.pm * BM + ai * HALF + wr * 64 + m * 16 + fr;
                    const float rs = rsl[ai * HALF + wr * 64 + m * 16 + fr];
                    if (pn == 0) {
#pragma unroll
                        for (int bj = 0; bj < 2; ++bj) { const int gp = bj * 2 + (wc >> 1), ks = (wc & 1) * 2 + (fq >> 1), hfq = fq & 1;
                            *(u32x4*)(U + ((size_t)(((row >> 5) * 4 + gp) * 4 + ks) * 2 + hfq) * 256 + (row & 31) * 8) = pack8(acc[ai][bj][m][0] * rs, acc[ai][bj][m][1] * rs); }
                    } else {
                        const int reg = (pn - 1) / 3, hb = ((pn - 1) % 3) * 4, shq = 2 * ((pn - 1) % 3);
                        bf16_t* dst = reg ? Kb : Q;
                        const int b = row / SEQ, ts = row % SEQ;
                        const bool rotw = (wc & 1) == 0;
                        f32x4 c0 = {1.f, 1.f, 1.f, 1.f}, c1 = c0, s0 = {0.f, 0.f, 0.f, 0.f}, s1 = s0;
                        if (rotw) { const f32x4* rp = (const f32x4*)(rot + (size_t)row * 16); c0 = rp[0]; c1 = rp[1]; s0 = rp[2]; s1 = rp[3]; }
#pragma unroll
                        for (int bj = 0; bj < 2; ++bj) {
                            const int head = hb + bj * 2 + (wc >> 1), d0 = (wc & 1) * 32 + 8 * fq;
                            f32x4 v0 = acc[ai][bj][m][0] * rs, v1 = acc[ai][bj][m][1] * rs;
                            if (rotw) {
                                f32x4 p0, p1;
#pragma unroll
                                for (int e = 0; e < 4; ++e) { p0[e] = shx(v0[e], 16, fq * 16 + fr); p1[e] = shx(v1[e], 16, fq * 16 + fr); }
                                if (fq < 2) { const float sg = (fq == 0) ? -1.f : 1.f; v0 = v0 * c0 + (p0 * s0) * sg; v1 = v1 * c1 + (p1 * s1) * sg; }
                            }
                            const int idxq = ts >> shq, sl = idxq & 31, slot = reg ? ((sl & 19) | ((sl & 4) << 1) | ((sl & 8) >> 1)) : sl;
                            *(u32x4*)(dst + ((size_t)(b * NH + head) * SEQ + (size_t)(ts & ((1 << shq) - 1)) * (SEQ >> shq) + (idxq & ~31)) * 64 + (d0 >> 3) * 256 + slot * 8) = pack8(v0, v1);
                        }
                    }
                }
        } else {
            const int g = u.pm, sh = 2 * g, per = 128 >> sh;
            const int tok0 = u.pn * BM, b = tok0 / SEQ, ts0 = tok0 % SEQ;
            const int n0 = wc * 32 + 8 * fq, rres = n0 >> (7 - sh), i0 = n0 & (per - 1);
#pragma unroll
            for (int ai = 0; ai < 2; ++ai)
#pragma unroll
                for (int m = 0; m < 4; ++m) {
                    const int vr = ai * HALF + wr * 64 + m * 16 + fr, hh = 4 * g + (vr >> 6), d = vr & 63;
                    bf16_t* base = VT + (size_t)(b * NH + hh) * 64 * SEQ + (size_t)rres * (SEQ >> sh) * 64 + (d >> 5) * 512 + (d & 31) * 8;
#pragma unroll
                    for (int bj = 0; bj < 2; ++bj) {
                        const int idx0 = ((ts0 + bj * HALF) >> sh) + i0;
                        f32x4 v0 = acc[ai][bj][m][0], v1 = acc[ai][bj][m][1];
                        const LAS float* rp = rsl + bj * HALF + (i0 << sh) + rres;
#pragma unroll
                        for (int e = 0; e < 4; ++e) { v0[e] *= rp[e << sh]; v1[e] *= rp[(e + 4) << sh]; }
                        *(u32x4*)(base + (size_t)(idx0 >> 5) * 2048 + ((idx0 >> 4) & 1) * 1024 + ((idx0 >> 3) & 1) * 256) = pack8(v0, v1);
                    }
                }
        }
    }
};

struct EpiRes {
    const bf16_t* resid; bf16_t* hb; float* ssp_out;
    static constexpr bool HAS_RS = false; const float* ssp = nullptr;
    __device__ __forceinline__ int rs_row(const Unit&) const { return 0; }
    __device__ __forceinline__ void prep(const Unit&, LAS float*, int) const {}
    __device__ __forceinline__ void operator()(const Acc& acc, const Unit& u, int wr, int wc, int fr, int fq, const LAS float* rsl) const {
        const int col0 = u.pn * BM + wc * 64 + 8 * fq;
        const size_t off0 = (size_t)(u.pm * BM + wr * 64 + fr) * DM + col0;
        u32x4 rw[2][4][2];
#pragma unroll
        for (int ai = 0; ai < 2; ++ai)
#pragma unroll
            for (int m = 0; m < 4; ++m)
#pragma unroll
                for (int bj = 0; bj < 2; ++bj) rw[ai][m][bj] = *(const u32x4*)(resid + off0 + (size_t)(ai * HALF + m * 16) * DM + bj * 32);
        asm volatile("" ::: "memory"); __builtin_amdgcn_sched_barrier(0);
#pragma unroll
        for (int ai = 0; ai < 2; ++ai)
#pragma unroll
            for (int m = 0; m < 4; ++m) {
                const int row = u.pm * BM + ai * HALF + wr * 64 + m * 16 + fr; float sq = 0.f; u32x4 o[2];
#pragma unroll
                for (int bj = 0; bj < 2; ++bj) {
                    const u32x4 w = rw[ai][m][bj];
                    const f32x4 r0 = {bf_lo(w.x), bf_hi(w.x), bf_lo(w.y), bf_hi(w.y)}, r1 = {bf_lo(w.z), bf_hi(w.z), bf_lo(w.w), bf_hi(w.w)};
                    const f32x4 v0 = acc[ai][bj][m][0] + r0, v1 = acc[ai][bj][m][1] + r1;
                    sq += (v0[0] * v0[0] + v0[1] * v0[1]) + (v0[2] * v0[2] + v0[3] * v0[3]) + (v1[0] * v1[0] + v1[1] * v1[1]) + (v1[2] * v1[2] + v1[3] * v1[3]);
                    o[bj] = pack8(v0, v1);
                }
                FULL_LINE_STORE(hb, DM, u.pm * BM + ai * HALF + wr * 64 + m * 16, col0, o[0], o[1]);
                sq += shx(sq, 16, fq * 16 + fr); sq += shx(sq, 32, fq * 16 + fr);
                if (fq == 0) ssp_out[(size_t)row * 16 + u.pn * 4 + wc] = sq;
            }
    }
};

struct EpiUp {
    const float* ssp; bf16_t* O;
    static constexpr bool HAS_RS = true;
    __device__ __forceinline__ int rs_row(const Unit& u) const { return u.pm * BM; }
    __device__ __forceinline__ void prep(const Unit& u, LAS float* rsl, int tid) const { if (tid < 256) rsl[tid] = row_rs(ssp, u.pm * BM + tid); }
    __device__ __forceinline__ void operator()(const Acc& acc, const Unit& u, int wr, int wc, int fr, int fq, const LAS float* rsl) const {
        const int col0 = u.pn * BM + wc * 64 + 8 * fq;
#pragma unroll
        for (int ai = 0; ai < 2; ++ai)
#pragma unroll
            for (int m = 0; m < 4; ++m) {
                const float rs = rsl[ai * HALF + wr * 64 + m * 16 + fr]; u32x4 o[2];
#pragma unroll
                for (int bj = 0; bj < 2; ++bj) {
                    f32x4 v0 = acc[ai][bj][m][0] * rs, v1 = acc[ai][bj][m][1] * rs;
#pragma unroll
                    for (int e = 0; e < 4; ++e) { v0[e] = fmaxf(v0[e], 0.f); v1[e] = fmaxf(v1[e], 0.f); }
                    v0 = v0 * v0; v1 = v1 * v1;
                    o[bj] = pack8(v0, v1);
                }
                FULL_LINE_STORE(O, FF, u.pm * BM + ai * HALF + wr * 64 + m * 16, col0, o[0], o[1]);
            }
    }
};

struct EpiPle {
    bf16_t* O;
    static constexpr bool HAS_RS = false; const float* ssp = nullptr;
    __device__ __forceinline__ int rs_row(const Unit&) const { return 0; }
    __device__ __forceinline__ void prep(const Unit&, LAS float*, int) const {}
    __device__ __forceinline__ void operator()(const Acc& acc, const Unit& u, int wr, int wc, int fr, int fq, const LAS float* rsl) const {
        const int col0 = u.pn * BM + wc * 64 + 8 * fq;
#pragma unroll
        for (int ai = 0; ai < 2; ++ai)
#pragma unroll
            for (int m = 0; m < 4; ++m) {
                const u32x4 o0 = pack8(acc[ai][0][m][0], acc[ai][0][m][1]), o1 = pack8(acc[ai][1][m][0], acc[ai][1][m][1]);
                FULL_LINE_STORE(O, DM, u.pm * BM + ai * HALF + wr * 64 + m * 16, col0, o0, o1);
            }
    }
};

struct EpiGate {
    const float* ssp; const bf16_t* HBr; bf16_t* EH; float* ssp_out;
    static constexpr bool HAS_RS = true;
    __device__ __forceinline__ int rs_row(const Unit& u) const { return u.pm * BM; }
    __device__ __forceinline__ void prep(const Unit& u, LAS float* rsl, int tid) const { if (tid < 256) rsl[tid] = row_rs(ssp, u.pm * BM + tid); }
    __device__ __forceinline__ void operator()(const Acc& acc, const Unit& u, int wr, int wc, int fr, int fq, const LAS float* rsl) const {
        const int col0 = u.pn * BM + wc * 64 + 8 * fq;
        const size_t off0 = (size_t)(u.pm * BM + wr * 64 + fr) * DM + col0;
#pragma unroll
        for (int ai = 0; ai < 2; ++ai) {
            u32x4 hwv[4][2], ewv[4][2];
#pragma unroll
            for (int m = 0; m < 4; ++m)
#pragma unroll
                for (int bj = 0; bj < 2; ++bj) { const size_t off = off0 + (size_t)(ai * HALF + m * 16) * DM + bj * 32; hwv[m][bj] = *(const u32x4*)(HBr + off); ewv[m][bj] = *(const u32x4*)(EH + off); }
            asm volatile("" ::: "memory"); __builtin_amdgcn_sched_barrier(0);
#pragma unroll
            for (int m = 0; m < 4; ++m) {
                const int row = u.pm * BM + ai * HALF + wr * 64 + m * 16 + fr; const float rs = rsl[ai * HALF + wr * 64 + m * 16 + fr]; float sq = 0.f; u32x4 o[2];
#pragma unroll
                for (int bj = 0; bj < 2; ++bj) {
                    const u32x4 ew = ewv[m][bj], hw = hwv[m][bj];
                    const f32x4 e0 = {bf_lo(ew.x), bf_hi(ew.x), bf_lo(ew.y), bf_hi(ew.y)}, e1 = {bf_lo(ew.z), bf_hi(ew.z), bf_lo(ew.w), bf_hi(ew.w)};
                    f32x4 v0 = {bf_lo(hw.x), bf_hi(hw.x), bf_lo(hw.y), bf_hi(hw.y)}, v1 = {bf_lo(hw.z), bf_hi(hw.z), bf_lo(hw.w), bf_hi(hw.w)};
#pragma unroll
                    for (int e = 0; e < 4; ++e) {
                        const float g0 = __builtin_amdgcn_rcpf(1.0f + __builtin_amdgcn_exp2f(-1.4426950408889634f * rs * acc[ai][bj][m][0][e])), g1 = __builtin_amdgcn_rcpf(1.0f + __builtin_amdgcn_exp2f(-1.4426950408889634f * rs * acc[ai][bj][m][1][e]));
                        v0[e] += g0 * e0[e]; v1[e] += g1 * e1[e];
                    }
                    sq += (v0[0] * v0[0] + v0[1] * v0[1]) + (v0[2] * v0[2] + v0[3] * v0[3]) + (v1[0] * v1[0] + v1[1] * v1[1]) + (v1[2] * v1[2] + v1[3] * v1[3]);
                    o[bj] = pack8(v0, v1);
                }
                FULL_LINE_STORE(EH, DM, u.pm * BM + ai * HALF + wr * 64 + m * 16, col0, o[0], o[1]);
                sq += shx(sq, 16, fq * 16 + fr); sq += shx(sq, 32, fq * 16 + fr);
                if (fq == 0) ssp_out[(size_t)row * 16 + u.pn * 4 + wc] = sq;
            }
        }
    }
};
}

struct Args { const float* in[15]; float* out; unsigned char* ws; unsigned long long seq0, seq1; int nseq, pad; };
typedef const __attribute__((address_space(4))) Args* ArgsP;

struct Frame {
    LAS unsigned char* lds; unsigned char* ws;
    int tid, lane, wave, G, bx;
};

__device__ __forceinline__ void p0_transpose_item(const float* W, const float* gain, int K, int N, bf16_t* WT, LAS float* scr, int item, int lane) {
    const int nblk = N / 32, kb = item / nblk, nb = item % nblk, k0 = 64 * kb, n0 = 32 * nb;
    const int kr = lane >> 3, nc = (lane & 7) * 4;
    f32x4 v[8]; float gk[8];
#pragma unroll
    for (int i = 0; i < 8; ++i) { v[i] = *(const f32x4*)(W + (size_t)(k0 + 8 * i + kr) * N + n0 + nc); gk[i] = gain ? gain[k0 + 8 * i + kr] : 1.0f; }
#pragma unroll
    for (int i = 0; i < 8; ++i) { LAS float* d = scr + (8 * i + kr) * 33 + nc; d[0] = v[i][0] * gk[i]; d[1] = v[i][1] * gk[i]; d[2] = v[i][2] * gk[i]; d[3] = v[i][3] * gk[i]; }
    asm volatile("s_waitcnt lgkmcnt(0)" ::: "memory");
    const int c = lane & 7;
#pragma unroll
    for (int j = 0; j < 4; ++j) { const int n = (lane >> 3) + 8 * j; const LAS float* s = scr + (8 * c) * 33 + n;
        u32x4 o; o.x = cvt_pk_bf16(s[0 * 33], s[1 * 33]); o.y = cvt_pk_bf16(s[2 * 33], s[3 * 33]); o.z = cvt_pk_bf16(s[4 * 33], s[5 * 33]); o.w = cvt_pk_bf16(s[6 * 33], s[7 * 33]);
        *(u32x4*)(WT + (size_t)(n0 + n) * K + k0 + 8 * c) = o; }
    asm volatile("s_waitcnt lgkmcnt(0)" ::: "memory");
}

__device__ __forceinline__ void sincos_acc(float ang, float& s, float& c) {
    const float kf = rintf(ang * 0.63661977236758134f);
    float r = fmaf(-kf, 1.5707855224609375f, ang);
    r = fmaf(-kf, 1.0804334124e-05f, r);
    const float r2 = r * r;
    float sp = 2.7557319e-6f; sp = fmaf(sp, r2, -1.9841270e-4f); sp = fmaf(sp, r2, 8.3333333e-3f); sp = fmaf(sp, r2, -1.6666667e-1f);
    const float sn = fmaf(r * r2, sp, r);
    float cp = -2.7557319e-7f; cp = fmaf(cp, r2, 2.4801587e-5f); cp = fmaf(cp, r2, -1.3888889e-3f); cp = fmaf(cp, r2, 4.1666667e-2f); cp = fmaf(cp, r2, -0.5f);
    const float cs = fmaf(cp, r2, 1.0f);
    const int q = ((int)kf) & 3;
    s = (q == 0) ? sn : (q == 1) ? cs : (q == 2) ? -sn : -cs;
    c = (q == 0) ? cs : (q == 1) ? -sn : (q == 2) ? -cs : sn;
}

__device__ __forceinline__ void p0_prologue(const Frame& F, ArgsP ap) {
    LAS float* scr = (LAS float*)(F.lds + F.wave * 16384);
    const int gw = F.bx * NWAVES + F.wave, NGW = F.G * NWAVES;
    constexpr int I_IN = 16 * 80, I_OUT = 16 * 32, I_UP = 16 * 128, I_DOWN = 64 * 32, I_GATE = 16 * 32, I_PLE = 4 * 32;
    constexpr int I_LAYER = I_IN + I_OUT + I_UP + I_DOWN + I_GATE + I_PLE;
    for (int it = gw; it < DEPTH * I_LAYER; it += NGW) {
        const int l = it / I_LAYER; int r = it % I_LAYER;
        unsigned char* wl = F.ws + WS_W + (size_t)l * W_LAYER;
        if (r < I_IN) { p0_transpose_item(ap->in[4] + (size_t)l * DM * NIN, ap->in[3] + l * DM, DM, NIN, (bf16_t*)(wl + W_IN), scr, r, F.lane); continue; } r -= I_IN;
        if (r < I_OUT) { p0_transpose_item(ap->in[7] + (size_t)l * DM * DM, nullptr, DM, DM, (bf16_t*)(wl + W_OUT), scr, r, F.lane); continue; } r -= I_OUT;
        if (r < I_UP) { p0_transpose_item(ap->in[9] + (size_t)l * DM * FF, ap->in[8] + l * DM, DM, FF, (bf16_t*)(wl + W_UP), scr, r, F.lane); continue; } r -= I_UP;
        if (r < I_DOWN) { p0_transpose_item(ap->in[10] + (size_t)l * FF * DM, nullptr, FF, DM, (bf16_t*)(wl + W_DOWN), scr, r, F.lane); continue; } r -= I_DOWN;
        if (r < I_GATE) { p0_transpose_item(ap->in[12] + (size_t)l * DM * DM, ap->in[11] + l * DM, DM, DM, (bf16_t*)(wl + W_GATE), scr, r, F.lane); continue; } r -= I_GATE;
        p0_transpose_item(ap->in[13] + (size_t)l * PLE * DM, nullptr, PLE, DM, (bf16_t*)(wl + W_PLE), scr, r, F.lane);
    }
    {
        bf16_t* hb = (bf16_t*)(F.ws + WS_E); float* ssp = (float*)(F.ws + WS_SSP); const float* xin = ap->in[0];
        for (int m0 = gw; m0 < T; m0 += 4 * NGW) {
            f32x4 v[4][4];
#pragma unroll
            for (int q = 0; q < 4; ++q) { const int m = (m0 + q * NGW < T) ? m0 + q * NGW : m0; const f32x4* xr = (const f32x4*)(xin + (size_t)m * DM) + F.lane;
#pragma unroll
                for (int j = 0; j < 4; ++j) v[q][j] = xr[64 * j]; }
#pragma unroll
            for (int q = 0; q < 4; ++q) { const int m = m0 + q * NGW; if (m < T) {
                u32x2* o8 = (u32x2*)(hb + (size_t)m * DM) + F.lane; float s = 0.f;
#pragma unroll
                for (int j = 0; j < 4; ++j) { const f32x4 w4 = v[q][j]; s += (w4[0] * w4[0] + w4[1] * w4[1]) + (w4[2] * w4[2] + w4[3] * w4[3]);
                    u32x2 w; w.x = cvt_pk_bf16(w4[0], w4[1]); w.y = cvt_pk_bf16(w4[2], w4[3]); o8[64 * j] = w; }
                s = wave_sum(s, F.lane);
                if (F.lane < 16) ssp[(size_t)m * 16 + F.lane] = (F.lane == 0) ? s : 0.f; } }
        }
    }
    {
        const int gt = F.bx * NTHREADS + F.tid, NGT = F.G * NTHREADS; constexpr int N4 = DEPTH * T * PLE / 4;
        const f32x4* src = (const f32x4*)ap->in[1]; u32x2* dst = (u32x2*)(F.ws + WS_PB);
        for (int i0 = gt; i0 < N4; i0 += 8 * NGT) {
            f32x4 v[8];
#pragma unroll
            for (int q = 0; q < 8; ++q) { const int i = (i0 + q * NGT < N4) ? i0 + q * NGT : i0; v[q] = src[i]; }
#pragma unroll
            for (int q = 0; q < 8; ++q) { const int i = i0 + q * NGT; if (i < N4) { u32x2 w; w.x = cvt_pk_bf16(v[q][0], v[q][1]); w.y = cvt_pk_bf16(v[q][2], v[q][3]); dst[i] = w; } }
        }
    }
    {
        const int gt = F.bx * NTHREADS + F.tid, NGT = F.G * NTHREADS;
        float* rot = (float*)(F.ws + WS_ROT); const int* pos = (const int*)ap->in[2];
        const float invf[8] = {1.0f, 0.1939227432012558f, 0.03760603070259094f, 0.007292664609849453f, 0.0014142135623842478f, 0.00027424818836152554f, 5.3182957344688475e-05f, 1.0313385246263351e-05f};
        for (int m = gt; m < T; m += NGT) {
            const float pf = (float)pos[m];
            f32x4 c0, c1, s0, s1;
#pragma unroll
            for (int i = 0; i < 4; ++i) { float s, c; sincos_acc(pf * invf[i], s, c); c0[i] = c; s0[i] = s; sincos_acc(pf * invf[i + 4], s, c); c1[i] = c; s1[i] = s; }
            f32x4* rp = (f32x4*)(rot + (size_t)m * 16); rp[0] = c0; rp[1] = c1; rp[2] = s0; rp[3] = s1;
        }
        bf16_t* pw = (bf16_t*)(F.ws + WS_POOLW); const float* pwi = ap->in[5];
        for (int e = gt; e < DEPTH * 4 * 64 * 64; e += NGT) {
            const int c = e & 63, d = (e >> 6) & 63, lg = e >> 12;
            const float v = pwi[((size_t)lg * 64 + c) * 64 + d];
            pw[e] = (bf16_t)(cvt_pk_bf16(v, 0.f) & 0xffffu);
        }
    }
}

template <int GP>
__device__ __forceinline__ void pool_task(const bf16_t* U, const bf16_t* PW, const float* pscale, bf16_t* MIX, int b, int ts0, int l31, int hf) {
    constexpr int WIN = 2 << GP, KSB = (GP == 3) ? 2 : 4;
    asm volatile("" : "+v"(l31), "+v"(hf));
    const int ts = ts0 + l31, row = b * SEQ + ts;
    const int cnt = (ts + 1 < WIN) ? (ts + 1) : WIN;
    const float rc = 1.0f / (float)cnt;
    f32x16 o[2];
#pragma unroll
    for (int e = 0; e < 16; ++e) { o[0][e] = 0.f; o[1][e] = 0.f; }
#pragma unroll
    for (int kb = 0; kb < 4; kb += KSB) {
        u32x4 wv[KSB][WIN]; bf16x8 wf[KSB][2];
#pragma unroll
        for (int k2 = 0; k2 < KSB; ++k2) {
            const int ks = kb + k2;
            const bf16_t* ub = U + ((size_t)GP * 4 + ks) * 512 + hf * 256;
#pragma unroll
            for (int i = 0; i < WIN; ++i) { const int rw = row - ((i < cnt) ? i : 0); wv[k2][i] = *(const u32x4*)(ub + (size_t)(rw >> 5) * 8192 + (rw & 31) * 8); }
#pragma unroll
            for (int dt = 0; dt < 2; ++dt) wf[k2][dt] = *(const bf16x8*)(PW + ((size_t)GP * 64 + 32 * dt + l31) * 64 + 16 * ks + 8 * hf);
        }
        asm volatile("" ::: "memory"); __builtin_amdgcn_sched_barrier(0);
#pragma unroll
        for (int k2 = 0; k2 < KSB; ++k2) {
            float sum[8], own[8];
            { const u32x4 w = wv[k2][0];
              own[0] = bf_lo(w.x); own[1] = bf_hi(w.x); own[2] = bf_lo(w.y); own[3] = bf_hi(w.y); own[4] = bf_lo(w.z); own[5] = bf_hi(w.z); own[6] = bf_lo(w.w); own[7] = bf_hi(w.w); }
#pragma unroll
            for (int e = 0; e < 8; ++e) sum[e] = own[e];
#pragma unroll
            for (int i = 1; i < WIN; ++i) {
                const float wgt = (i < cnt) ? 1.0f : 0.0f; const u32x4 w = wv[k2][i];
                sum[0] += wgt * bf_lo(w.x); sum[1] += wgt * bf_hi(w.x); sum[2] += wgt * bf_lo(w.y); sum[3] += wgt * bf_hi(w.y);
                sum[4] += wgt * bf_lo(w.z); sum[5] += wgt * bf_hi(w.z); sum[6] += wgt * bf_lo(w.w); sum[7] += wgt * bf_hi(w.w);
            }
            u32x4 yw;
            yw.x = cvt_pk_bf16(sum[0] * rc - own[0], sum[1] * rc - own[1]); yw.y = cvt_pk_bf16(sum[2] * rc - own[2], sum[3] * rc - own[3]);
            yw.z = cvt_pk_bf16(sum[4] * rc - own[4], sum[5] * rc - own[5]); yw.w = cvt_pk_bf16(sum[6] * rc - own[6], sum[7] * rc - own[7]);
            const bf16x8 yf = __builtin_bit_cast(bf16x8, yw);
#pragma unroll
            for (int dt = 0; dt < 2; ++dt) o[dt] = __builtin_amdgcn_mfma_f32_32x32x16_bf16(wf[k2][dt], yf, o[dt], 0, 0, 0);
        }
    }
    bf16_t* orow = MIX + (size_t)row * DM + GP * 64;
#pragma unroll
    for (int dt = 0; dt < 2; ++dt)
#pragma unroll
        for (int p = 0; p < 2; ++p) {
            const int d = 32 * dt + 16 * p + 4 * hf;
            const f32x4 sa = *(const f32x4*)(pscale + GP * 64 + d), sb = *(const f32x4*)(pscale + GP * 64 + d + 8);
            const unsigned ax = cvt_pk_bf16(o[dt][8 * p + 0] * sa[0], o[dt][8 * p + 1] * sa[1]), ay = cvt_pk_bf16(o[dt][8 * p + 2] * sa[2], o[dt][8 * p + 3] * sa[3]);
            const unsigned bx = cvt_pk_bf16(o[dt][8 * p + 4] * sb[0], o[dt][8 * p + 5] * sb[1]), by = cvt_pk_bf16(o[dt][8 * p + 6] * sb[2], o[dt][8 * p + 7] * sb[3]);
            const auto r0 = __builtin_amdgcn_permlane32_swap(ax, bx, false, false); const auto r1 = __builtin_amdgcn_permlane32_swap(ay, by, false, false);
            const u32x4 w = {r0[0], r1[0], r0[1], r1[1]};
            *(u32x4*)(orow + 32 * dt + 16 * p + 8 * hf) = w;
        }
}

__device__ __forceinline__ void attn_pool_phase(const Frame& F, ArgsP ap, int layer) {
    LAS float* lse = (LAS float*)F.lds;
    const bf16_t* U = (const bf16_t*)(F.ws + WS_BIG + BIG_U);
    const bf16_t* Q = (const bf16_t*)(F.ws + WS_BIG + BIG_Q);
    const bf16_t* Kb = (const bf16_t*)(F.ws + WS_BIG + BIG_K);
    const bf16_t* VT = (const bf16_t*)(F.ws + WS_BIG + BIG_VT);
    bf16_t* MIX = (bf16_t*)(F.ws + WS_BIG + BIG_MIX);
    const bf16_t* PW = (const bf16_t*)(F.ws + WS_POOLW) + (size_t)layer * 4 * 64 * 64;
    const float* pscale = ap->in[6] + layer * 256;
    const int lane = F.lane, l31 = lane & 31, hf = lane >> 5;
    const float NEG = -INFINITY;
    for (int unit = F.bx; unit < 256; unit += F.G) {
        const int pair = (unit & 7) * 2 + (unit >> 7), b = pair >> 2, j = pair & 3, span = (unit >> 3) & 15;
        const int ts_base = span * 512;
        bf16x8 qf[4], kf[5][4];
#define LOAD_QK(ti_) do { int ln_ = F.lane; asm volatile("" : "+v"(ln_)); const int g_ = (ti_) >> 4, x_ = (ti_) & 15, sh_ = 2 * g_, tpr_ = 16 >> sh_, r_ = x_ / tpr_, i0_ = (ts_base >> sh_) + 32 * (x_ % tpr_); \
            const size_t hrow_ = (size_t)(b * NH + 4 * g_ + j) * SEQ + (size_t)r_ * (SEQ >> sh_); const bf16_t* Qs_ = Q + hrow_ * 64; const bf16_t* Ks_ = Kb + hrow_ * 64; \
            _Pragma("unroll") for (int ks = 0; ks < 4; ++ks) qf[ks] = *(const bf16x8*)(Qs_ + (size_t)i0_ * 64 + ks * 512 + ln_ * 8); \
            _Pragma("unroll") for (int kt = 0; kt < 5; ++kt) { const int kb_ = i0_ - 128 + 32 * kt, kbc_ = kb_ < 0 ? 0 : kb_; \
                _Pragma("unroll") for (int ks = 0; ks < 4; ++ks) kf[kt][ks] = *(const bf16x8*)(Ks_ + (size_t)kbc_ * 64 + ks * 512 + ln_ * 8); } } while (0)
        LOAD_QK(F.wave);
        for (int ti = F.wave; ti < 48; ti += NWAVES) {
            int lane = F.lane; asm volatile("" : "+v"(lane));
            const int l31 = lane & 31, hf = lane >> 5;
            const int g = ti >> 4, x = ti & 15, sh = 2 * g;
            const int tpr = 16 >> sh, r = x / tpr, i0 = (ts_base >> sh) + 32 * (x % tpr);
            const int hh = 4 * g + j;
            const size_t hrow = (size_t)(b * NH + hh) * SEQ + (size_t)r * (SEQ >> sh);
            const bf16_t* Qs = Q + hrow * 64;
            const bf16_t* Ks = Kb + hrow * 64;
            const bf16_t* VTs = VT + hrow * 64;
            const int qi = i0 + l31, tq = (qi << sh) + r;
            f32x16 s[5];
            asm volatile("" ::: "memory"); __builtin_amdgcn_sched_barrier(0);
#pragma unroll
            for (int kt = 0; kt < 5; ++kt) {
#pragma unroll
                for (int e = 0; e < 16; ++e) s[kt][e] = 0.f;
#pragma unroll
                for (int ks = 0; ks < 4; ++ks) s[kt] = __builtin_amdgcn_mfma_f32_32x32x16_bf16(kf[kt][ks], qf[ks], s[kt], 0, 0, 0);
            }
            bf16x8 vf[5][2][2];
#define LOAD_VF(kt_) do { const int kb_ = i0 - 128 + 32 * (kt_), kbc_ = kb_ < 0 ? 0 : kb_; const bf16_t* vblk_ = VTs + (size_t)(kbc_ >> 5) * 2048 + lane * 8; \
                _Pragma("unroll") for (int s2 = 0; s2 < 2; ++s2) _Pragma("unroll") for (int dt = 0; dt < 2; ++dt) vf[kt_][s2][dt] = *(const bf16x8*)(vblk_ + (s2 * 2 + dt) * 512); } while (0)
            LOAD_VF(0); LOAD_VF(1); LOAD_VF(2); LOAD_VF(3); LOAD_VF(4);
            asm volatile("" ::: "memory"); __builtin_amdgcn_sched_barrier(0);
            float mx = NEG;
#pragma unroll
            for (int kt = 0; kt < 5; ++kt) {
                const bool tv = (i0 - 128 + 32 * kt) >= 0;
#pragma unroll
                for (int e = 0; e < 16; ++e) {
                    const int kk = 16 * (e >> 3) + 8 * hf + (e & 7);
                    const bool valid = tv && (kt == 0 ? (kk >= l31) : kt == 4 ? (kk <= l31) : true);
                    s[kt][e] = valid ? s[kt][e] : NEG;
                    mx = fmaxf(mx, s[kt][e]);
                }
            }
            mx = fmaxf(mx, shx(mx, 32, lane));
            const float cs = 0.125f * 1.4426950408889634f;
            const float mc = mx * cs;
            float lsum = 0.f;
            f32x16 o[2];
#pragma unroll
            for (int e = 0; e < 16; ++e) { o[0][e] = 0.f; o[1][e] = 0.f; }
#pragma unroll
            for (int kt = 0; kt < 5; ++kt) {
#pragma unroll
                for (int e = 0; e < 16; ++e) { const float p = __builtin_amdgcn_exp2f(s[kt][e] * cs - mc); s[kt][e] = p; lsum += p; }
#pragma unroll
                for (int s2 = 0; s2 < 2; ++s2) {
                    u32x4 pw;
                    pw.x = cvt_pk_bf16(s[kt][8 * s2 + 0], s[kt][8 * s2 + 1]); pw.y = cvt_pk_bf16(s[kt][8 * s2 + 2], s[kt][8 * s2 + 3]);
                    pw.z = cvt_pk_bf16(s[kt][8 * s2 + 4], s[kt][8 * s2 + 5]); pw.w = cvt_pk_bf16(s[kt][8 * s2 + 6], s[kt][8 * s2 + 7]);
                    const bf16x8 pf = __builtin_bit_cast(bf16x8, pw);
#pragma unroll
                    for (int dt = 0; dt < 2; ++dt) o[dt] = __builtin_amdgcn_mfma_f32_32x32x16_bf16(vf[kt][s2][dt], pf, o[dt], 0, 0, 0);
                }
            }
#undef LOAD_VF
            { const int tn_ = (ti + NWAVES < 48) ? ti + NWAVES : ti; LOAD_QK(tn_); }
            asm volatile("" ::: "memory"); __builtin_amdgcn_sched_barrier(0);
            lsum += shx(lsum, 32, lane);
            const float inv = 1.0f / lsum;
            bf16_t* orow = MIX + (size_t)(b * SEQ + tq) * DM + 256 + hh * 64;
#pragma unroll
            for (int dt = 0; dt < 2; ++dt)
#pragma unroll
                for (int p = 0; p < 2; ++p) {
                    const unsigned ax = cvt_pk_bf16(o[dt][8 * p + 0] * inv, o[dt][8 * p + 1] * inv), ay = cvt_pk_bf16(o[dt][8 * p + 2] * inv, o[dt][8 * p + 3] * inv);
                    const unsigned bx = cvt_pk_bf16(o[dt][8 * p + 4] * inv, o[dt][8 * p + 5] * inv), by = cvt_pk_bf16(o[dt][8 * p + 6] * inv, o[dt][8 * p + 7] * inv);
                    const auto r0 = __builtin_amdgcn_permlane32_swap(ax, bx, false, false); const auto r1 = __builtin_amdgcn_permlane32_swap(ay, by, false, false);
                    const u32x4 w = {r0[0], r1[0], r0[1], r1[1]};
                    *(u32x4*)(orow + 32 * dt + 16 * p + 8 * hf) = w;
                }
            if (hf == 0) lse[g * 512 + (tq - ts_base)] = mx * 0.125f + __logf(lsum);
        }
#undef LOAD_QK
        {
            const int ts0 = ts_base + 128 * j + 32 * (F.wave >> 1);
            if (F.wave & 1) { pool_task<0>(U, PW, pscale, MIX, b, ts0, l31, hf); pool_task<1>(U, PW, pscale, MIX, b, ts0, l31, hf); pool_task<2>(U, PW, pscale, MIX, b, ts0, l31, hf); }
            else            { pool_task<3>(U, PW, pscale, MIX, b, ts0, l31, hf); }
        }
        __syncthreads();
        for (int it0 = F.tid; it0 < 512 * 24; it0 += 12 * NTHREADS) {
            u32x4 wv[12]; u32x4* pp[12]; float wt[12];
#pragma unroll
            for (int q = 0; q < 12; ++q) {
                const int it = it0 + q * NTHREADS, tl = it / 24, rem = it % 24, g = rem >> 3, ch = rem & 7;
                pp[q] = (u32x4*)(MIX + (size_t)(b * SEQ + ts_base + tl) * DM + 256 + (4 * g + j) * 64 + ch * 8);
                wv[q] = *pp[q];
                const float l0 = lse[tl], l1 = lse[512 + tl], l2 = lse[1024 + tl];
                const float mxl = fmaxf(l0, fmaxf(l1, l2));
                const float e0 = __expf(l0 - mxl), e1 = __expf(l1 - mxl), e2 = __expf(l2 - mxl);
                wt[q] = ((g == 0) ? e0 : (g == 1) ? e1 : e2) / (e0 + e1 + e2);
            }
#pragma unroll
            for (int q = 0; q < 12; ++q) {
                const u32x4 w = wv[q]; const float t = wt[q]; u32x4 o;
                o.x = cvt_pk_bf16(bf_lo(w.x) * t, bf_hi(w.x) * t); o.y = cvt_pk_bf16(bf_lo(w.y) * t, bf_hi(w.y) * t);
                o.z = cvt_pk_bf16(bf_lo(w.z) * t, bf_hi(w.z) * t); o.w = cvt_pk_bf16(bf_lo(w.w) * t, bf_hi(w.w) * t);
                *pp[q] = o;
            }
        }
        __syncthreads();
    }
}

__device__ __forceinline__ void final_norm_phase(const Frame& F, ArgsP ap) {
    const float* fin = ap->in[14]; float* outp = ap->out;
    const bf16_t* hsrc = (const bf16_t*)(F.ws + WS_E);
    const int gw = F.bx * NWAVES + F.wave, NGW = F.G * NWAVES;
    f32x4 gv[4];
#pragma unroll
    for (int j = 0; j < 2; ++j) { gv[2 * j] = *(const f32x4*)(fin + 512 * j + 8 * F.lane); gv[2 * j + 1] = *(const f32x4*)(fin + 512 * j + 8 * F.lane + 4); }
    for (int m0 = gw; m0 < T; m0 += 4 * NGW) {
        u32x4 w[4][2];
#pragma unroll
        for (int q = 0; q < 4; ++q) { const int m = (m0 + q * NGW < T) ? m0 + q * NGW : m0;
#pragma unroll
            for (int j = 0; j < 2; ++j) w[q][j] = *(const u32x4*)(hsrc + (size_t)m * DM + 512 * j + 8 * F.lane); }
        asm volatile("" ::: "memory"); __builtin_amdgcn_sched_barrier(0);
#pragma unroll
        for (int q = 0; q < 4; ++q) { const int m = m0 + q * NGW; if (m < T) {
            f32x4 v[4]; float s = 0.f;
#pragma unroll
            for (int j = 0; j < 2; ++j) { const u32x4 x = w[q][j];
                v[2 * j] = (f32x4){bf_lo(x.x), bf_hi(x.x), bf_lo(x.y), bf_hi(x.y)}; v[2 * j + 1] = (f32x4){bf_lo(x.z), bf_hi(x.z), bf_lo(x.w), bf_hi(x.w)}; }
#pragma unroll
            for (int j = 0; j < 4; ++j) s += (v[j][0] * v[j][0] + v[j][1] * v[j][1]) + (v[j][2] * v[j][2] + v[j][3] * v[j][3]);
            const float rs = 1.0f / sqrtf(wave_sum(s, F.lane) * (1.0f / DM) + EPS);
#pragma unroll
            for (int j = 0; j < 2; ++j) { float* o = outp + (size_t)m * DM + 512 * j + 8 * F.lane; *(f32x4*)o = v[2 * j] * rs * gv[2 * j]; *(f32x4*)(o + 4) = v[2 * j + 1] * rs * gv[2 * j + 1]; }
        } }
    }
}

#define XB_TMO      128
#define XB_XCNT(j)  (256  + 64 * (j))
#define XB_XSUB(j)  (1280 + 64 * (j))
#define XB_XGEN(j)  (2304 + 64 * (j))
#define XB_TOP      3328
#define XB_TOPGEN   3392
#define XCD_BAR_WORDS 3456
#define XB_SPIN_CAP (1u << 22)
__device__ __forceinline__ unsigned xb_ld(unsigned* p)              { return __hip_atomic_load(p, __ATOMIC_RELAXED, __HIP_MEMORY_SCOPE_AGENT); }
__device__ __forceinline__ unsigned xb_add(unsigned* p, unsigned v) { return __hip_atomic_fetch_add(p, v, __ATOMIC_RELAXED, __HIP_MEMORY_SCOPE_AGENT); }
__device__ __forceinline__ unsigned xb_xcc_id() { return (unsigned)__builtin_amdgcn_s_getreg((3 << 11) | 20) & 0xFu; }
#define XB_SPIN(cond, bar) do { unsigned _sp = 0; while (cond) { __builtin_amdgcn_s_sleep(1); \
    if ((++_sp & 255u) == 0u) { if (xb_ld(&(bar)[XB_TMO])) break; if (_sp > XB_SPIN_CAP) { atomicAdd(&(bar)[XB_TMO], 1u); break; } } } } while (0)
__device__ __forceinline__ void xcd_barrier_complete(unsigned* bar, unsigned x, unsigned& nloc, unsigned& nx) {
    const unsigned G = gridDim.x;
    unsigned sum, cnt, mine, sp = 0u;
    for (;;) {
        sum = 0u; cnt = 0u; mine = 0u;
#pragma unroll
        for (unsigned j = 0; j < 16; ++j) { const unsigned c = xb_ld(&bar[XB_XCNT(j)]); sum += c; cnt += (c > 0u) ? 1u : 0u; mine = (j == x) ? c : mine; }
        if (sum == G) break;
        __builtin_amdgcn_s_sleep(1);
        if ((++sp & 255u) == 0u) { if (xb_ld(&bar[XB_TMO])) break; if (sp > XB_SPIN_CAP) { atomicAdd(&bar[XB_TMO], 1u); break; } }
    }
    nloc = mine > 0u ? mine : 1u; nx = cnt > 0u ? cnt : 1u;
}
__device__ __forceinline__ void xcd_barrier(unsigned* bar, volatile LAS unsigned* st) {
    asm volatile("s_waitcnt vmcnt(0)" ::: "memory");
    __syncthreads();
    if (threadIdx.x == 0) {
        const unsigned x = xb_xcc_id();
        __builtin_amdgcn_s_waitcnt(0);
        unsigned nloc = st[0], nx = st[1];
        if (nloc == 0u) { xcd_barrier_complete(bar, x, nloc, nx); st[0] = nloc; st[1] = nx; }
        const unsigned old = xb_add(&bar[XB_XSUB(x)], 1u);
        const unsigned gen = old / nloc;
        if (old + 1u == (gen + 1u) * nloc) {
            __builtin_amdgcn_fence(__ATOMIC_RELEASE, "agent");
            asm volatile("s_waitcnt vmcnt(0)" ::: "memory");
            const unsigned og = xb_add(&bar[XB_TOP], 1u);
            const unsigned tg = og / nx;
            if (og + 1u == (tg + 1u) * nx) xb_add(&bar[XB_TOPGEN], 1u);
            else XB_SPIN(xb_ld(&bar[XB_TOPGEN]) == tg, bar);
            __builtin_amdgcn_fence(__ATOMIC_ACQUIRE, "agent");
            xb_add(&bar[XB_XGEN(x)], 1u);
            asm volatile("s_waitcnt vmcnt(0)" ::: "memory");
        } else {
            XB_SPIN(xb_ld(&bar[XB_XGEN(x)]) == gen, bar);
            __builtin_amdgcn_fence(__ATOMIC_ACQUIRE, "agent");
            asm volatile("s_waitcnt vmcnt(0)" ::: "memory");
        }
    }
    __syncthreads();
}

#ifndef PHMASK
#define PHMASK 511
#endif
#ifndef REPMASK
#define REPMASK 0
#endif
#ifndef EXTRA_SYNCS
#define EXTRA_SYNCS 0
#endif
constexpr int N_PHASES = 2 + 6 * DEPTH;
__global__ void __launch_bounds__(NTHREADS, 2) fwd_megakernel(Args args) {
    extern __shared__ __attribute__((aligned(16))) unsigned char lds_raw[];
    cg::grid_group grid = cg::this_grid();
    Frame F;
    F.lds = (LAS unsigned char*)lds_raw;
    F.G = gridDim.x; F.bx = blockIdx.x;
    ArgsP ap0 = (ArgsP)__builtin_amdgcn_kernarg_segment_ptr();
    const int wave_id = __builtin_amdgcn_readfirstlane(threadIdx.x >> 6);
    volatile LAS unsigned* bst = (volatile LAS unsigned*)(F.lds + pg8::STAGE_BYTES + 2048);
    if (threadIdx.x == 0) { bst[0] = 0u; bst[1] = 0u; (void)xb_add((unsigned*)(ap0->ws + WS_BAR) + XB_XCNT(xb_xcc_id()), 1u); }
    __syncthreads();
    const int nseq = ap0->nseq; const unsigned long long seq0 = ap0->seq0, seq1 = ap0->seq1;
    for (int idx = 0; idx < nseq; ++idx) {
        const int ph = (int)(((idx < 16) ? (seq0 >> (4 * idx)) : (seq1 >> (4 * (idx - 16)))) & 15ull);
        unsigned zero_ = 0u; asm volatile("" : "+v"(zero_));
        int tid = wave_id * 64 + (int)__builtin_amdgcn_mbcnt_hi(~0u, __builtin_amdgcn_mbcnt_lo(~0u, zero_)); asm volatile("" : "+v"(tid));
        ArgsP ap = ap0; asm volatile("" : "+s"(ap));
        F.tid = tid; F.lane = tid & 63; F.wave = __builtin_amdgcn_readfirstlane(tid >> 6);
        unsigned char* ws = ap->ws; F.ws = ws;
        float* sspb = (float*)(ws + WS_SSP);
        bf16_t* HB = (bf16_t*)(ws + WS_HB);
        bf16_t* EH = (bf16_t*)(ws + WS_E);
        if (ph == 0) { if (PHMASK & 1) p0_prologue(F, ap); }
        else if (ph == N_PHASES - 1) { if (PHMASK & 2) final_norm_phase(F, ap); }
        else if (ph >= N_PHASES) { }
        else {
            const int l = (ph - 1) / 6, k = (ph - 1) % 6;
            unsigned char* wl = ws + WS_W + (size_t)l * W_LAYER;
            float* ssp0 = sspb + (size_t)(3 * l + 0) * (SSP_STRIDE / 4);
            float* ssp1 = sspb + (size_t)(3 * l + 1) * (SSP_STRIDE / 4);
            float* ssp2 = sspb + (size_t)(3 * l + 2) * (SSP_STRIDE / 4);
            float* ssp3 = sspb + (size_t)(3 * l + 3) * (SSP_STRIDE / 4);
            if (k == 0) { if (PHMASK & 4) {
                pg8::SchedIn S; S.init(EH, (const bf16_t*)(wl + W_IN), F.G, F.bx);
                pg8::EpiIn E{ssp0, ws};
                pg8::gemm_phase<pg8::EpiIn, pg8::SchedIn>(F.lds, F.wave, DM, S, E); }
            } else if (k == 1) {
                if (PHMASK & 8) attn_pool_phase(F, ap, l);
            } else if (k == 2) { if (PHMASK & 16) {
                pg8::SchedStd S; S.init((const bf16_t*)(ws + WS_BIG + BIG_MIX), (const bf16_t*)(wl + W_OUT), T, DM, DM, F.G, F.bx);
                pg8::EpiRes E{EH, HB, ssp1};
                pg8::gemm_phase<pg8::EpiRes, pg8::SchedStd>(F.lds, F.wave, DM, S, E); }
            } else if (k == 3) {
                if (PHMASK & 32) { pg8::SchedStd S; S.init(HB, (const bf16_t*)(wl + W_UP), T, FF, DM, F.G, F.bx);
                  pg8::EpiUp E{ssp1, (bf16_t*)(ws + WS_BIG)};
                  pg8::gemm_phase<pg8::EpiUp, pg8::SchedStd>(F.lds, F.wave, DM, S, E); }
                if (PHMASK & 64) { pg8::SchedStd S; S.init((const bf16_t*)(ws + WS_PB) + (size_t)l * T * PLE, (const bf16_t*)(wl + W_PLE), T, DM, PLE, F.G, F.bx);
                  pg8::EpiPle E{EH};
                  pg8::gemm_phase<pg8::EpiPle, pg8::SchedStd>(F.lds, F.wave, PLE, S, E); }
            } else if (k == 4) { if (PHMASK & 128) {
                pg8::SchedStd S; S.init((const bf16_t*)(ws + WS_BIG), (const bf16_t*)(wl + W_DOWN), T, DM, FF, F.G, F.bx);
                pg8::EpiRes E{HB, HB, ssp2};
                pg8::gemm_phase<pg8::EpiRes, pg8::SchedStd>(F.lds, F.wave, FF, S, E); }
            } else { if (PHMASK & 256) {
                pg8::SchedStd S; S.init(HB, (const bf16_t*)(wl + W_GATE), T, DM, DM, F.G, F.bx);
                pg8::EpiGate E{ssp2, HB, EH, ssp3};
                pg8::gemm_phase<pg8::EpiGate, pg8::SchedStd>(F.lds, F.wave, DM, S, E); }
            }
        }
        if (idx + 1 < nseq) xcd_barrier((unsigned*)(ws + WS_BAR), bst);
        if (nseq > 1000) grid.sync();
    }
}

extern "C" void kernel_launch(void* const* d_in, const int* in_sizes, int n_in, void* d_out, int out_size, void* d_ws, size_t ws_size, hipStream_t stream) {
    static int grid = 0;
    if (grid == 0) {
        if (n_in != 15 || in_sizes[0] != T * DM || out_size != T * DM || ws_size < WS_END) {
            fprintf(stderr, "kernel_launch: unexpected problem (n_in %d, in0 %d, out %d, ws %zu; need ws >= %zu); nothing launched\n", n_in, n_in > 0 ? in_sizes[0] : -1, out_size, ws_size, (size_t)WS_END);
            grid = -1; return; }
        int dev = 0, cus = 0, per_cu = 0;
        if (hipGetDevice(&dev) != hipSuccess || hipDeviceGetAttribute(&cus, hipDeviceAttributeMultiprocessorCount, dev) != hipSuccess) { grid = -1; return; }
        if (hipFuncSetAttribute((const void*)fwd_megakernel, hipFuncAttributeMaxDynamicSharedMemorySize, LDS_BYTES) != hipSuccess) { fprintf(stderr, "kernel_launch: hipFuncSetAttribute failed\n"); grid = -1; return; }
        if (hipOccupancyMaxActiveBlocksPerMultiprocessor(&per_cu, (const void*)fwd_megakernel, NTHREADS, LDS_BYTES) != hipSuccess || per_cu < 1) { fprintf(stderr, "kernel_launch: occupancy query failed (%d)\n", per_cu); (void)hipGetLastError(); grid = -1; return; }
        grid = cus * per_cu;
    }
    if (grid < 0) return;
    Args a{};
    for (int i = 0; i < 15; ++i) a.in[i] = (const float*)d_in[i];
    a.out = (float*)d_out; a.ws = (unsigned char*)d_ws;
    { int n = 0; for (int ph = 0; ph < N_PHASES; ++ph) { const int kc = (ph == 0) ? 0 : (ph == N_PHASES - 1) ? 7 : 1 + (ph - 1) % 6; const bool idem = kc == 0 || kc == 1 || kc == 2 || kc == 4 || (kc == 3 && ph < 7);
        const int nrep = (idem && ((REPMASK >> kc) & 1)) ? 2 : 1;
        if (ph == 1) for (int r = 0; r < EXTRA_SYNCS; ++r) { if (n < 16) a.seq0 |= 14ull << (4 * n); else a.seq1 |= 14ull << (4 * (n - 16)); ++n; }
        for (int r = 0; r < nrep; ++r) { if (n < 16) a.seq0 |= (unsigned long long)ph << (4 * n); else a.seq1 |= (unsigned long long)ph << (4 * (n - 16)); ++n; } }
      a.nseq = n; }
    if (hipMemsetAsync((char*)d_ws + WS_BAR, 0, XCD_BAR_WORDS * 4, stream) != hipSuccess) { fprintf(stderr, "kernel_launch: hipMemsetAsync failed\n"); return; }
    void* kargs[] = {&a};
    hipError_t e = hipLaunchCooperativeKernel((const void*)fwd_megakernel, dim3(grid), dim3(NTHREADS), kargs, LDS_BYTES, stream);
    if (e != hipSuccess) fprintf(stderr, "kernel_launch: cooperative launch failed: %s (grid %d)\n", hipGetErrorString(e), grid);
}
```

```cpp
#include <hip/hip_runtime.h>
#include <hip/hip_cooperative_groups.h>
#include <cstdio>
#include <cstdint>
namespace cg = cooperative_groups;

#define LAS __attribute__((address_space(3)))
typedef unsigned short bf16_t;
typedef short bf16x8 __attribute__((ext_vector_type(8)));
typedef float f32x4 __attribute__((ext_vector_type(4)));
typedef float f32x16 __attribute__((ext_vector_type(16)));
typedef unsigned u32x4 __attribute__((ext_vector_type(4)));
typedef unsigned u32x2 __attribute__((ext_vector_type(2)));

constexpr int BATCH = 4, SEQ = 8192, DM = 1024, T = BATCH * SEQ, NIN = 2560, FF = 4096, PLE = 256, DEPTH = 2, NH = 12;
constexpr float EPS = 1e-6f;
constexpr int NWAVES = 8, NTHREADS = 512;
constexpr int LDS_BYTES = 135168;

constexpr size_t MiB = 1u << 20;
constexpr size_t WS_ROT = 0;
constexpr size_t WS_SSP = 2 * MiB;
constexpr size_t SSP_STRIDE = 2 * MiB;
constexpr size_t WS_POOLW = 16 * MiB;
constexpr size_t WS_BAR = 16 * MiB + 512 * 1024;
constexpr size_t WS_W = 17 * MiB;
constexpr size_t W_LAYER = 26 * MiB, W_IN = 0, W_OUT = 5 * MiB, W_UP = 7 * MiB, W_DOWN = 15 * MiB, W_GATE = 23 * MiB, W_PLE = 25 * MiB;
constexpr size_t WS_HB = 69 * MiB;
constexpr size_t WS_PB = 133 * MiB;
constexpr size_t WS_E = 165 * MiB;
constexpr size_t WS_BIG = 229 * MiB;
constexpr size_t BIG_U = 0, BIG_Q = 16 * MiB, BIG_K = 64 * MiB, BIG_VT = 112 * MiB, BIG_MIX = 160 * MiB;
constexpr size_t WS_END = 485 * MiB;

__device__ __forceinline__ unsigned cvt_pk_bf16(float lo, float hi) { unsigned r; asm volatile("v_cvt_pk_bf16_f32 %0, %1, %2" : "=v"(r) : "v"(lo), "v"(hi)); return r; }
__device__ __forceinline__ u32x4 pack8(f32x4 a, f32x4 b) { u32x4 w; w.x = cvt_pk_bf16(a[0], a[1]); w.y = cvt_pk_bf16(a[2], a[3]); w.z = cvt_pk_bf16(b[0], b[1]); w.w = cvt_pk_bf16(b[2], b[3]); return w; }
__device__ __forceinline__ float bf_lo(unsigned w) { return __uint_as_float(w << 16); }
__device__ __forceinline__ float bf_hi(unsigned w) { return __uint_as_float(w & 0xffff0000u); }
__device__ __forceinline__ float shx(float v, int mask, int lane) { return __int_as_float(__builtin_amdgcn_ds_bpermute((lane ^ mask) << 2, __float_as_int(v))); }
__device__ __forceinline__ float wave_sum(float v, int lane) {
#pragma unroll
    for (int o = 1; o < 64; o <<= 1) v += shx(v, o, lane);
    return v;
}
__device__ __forceinline__ float row_rs(const float* ssp, int row) {
    const f32x4* p = (const f32x4*)(ssp + (size_t)row * 16);
    const f32x4 a = p[0], b = p[1], c = p[2], d = p[3];
    const float s = ((a[0] + a[1]) + (a[2] + a[3])) + ((b[0] + b[1]) + (b[2] + b[3])) + ((c[0] + c[1]) + (c[2] + c[3])) + ((d[0] + d[1]) + (d[2] + d[3]));
    return __builtin_amdgcn_rsqf(s * (1.0f / DM) + EPS);
}

__device__ __forceinline__ int lane_now() { unsigned z = 0u; asm volatile("" : "+v"(z)); return (int)__builtin_amdgcn_mbcnt_hi(~0u, __builtin_amdgcn_mbcnt_lo(~0u, z)); }

namespace pg8 {
constexpr int BM = 256, BK = 64, HALF = 128, HTB = HALF * BK * 2, STAGE_BYTES = 8 * HTB;
__host__ __device__ __forceinline__ int lds_byte(int r, int c) { const int st = (r >> 4) * 2 + (c >> 5), rr = r & 15, cc = c & 31, ob = rr * 64 + cc * 2; return st * 1024 + (ob ^ (((ob >> 9) & 1) << 5)); }
__host__ __device__ __forceinline__ void stage_rc(int b, int& R, int& C) { const int st = b / 1024, sb = b % 1024, swz = sb ^ (((sb >> 9) & 1) << 5); R = (st >> 1) * 16 + swz / 64; C = (st & 1) * 32 + (swz % 64) / 2; }
__host__ __device__ __forceinline__ int perm32(int rho) { const int n = rho >> 4, i = rho & 15; return 8 * (i >> 2) + 4 * n + (i & 3); }

struct Unit { int pm, pn, kind; };
__device__ __forceinline__ int remap8(int L, int n) { return (L % 8) * (n / 8) + L / 8; }

struct SchedStd {
    int nM, nN, nwg, G, c; const char* A; const char* B; size_t tstep;
    __device__ __forceinline__ void init(const bf16_t* A_, const bf16_t* B_, int M, int N, int K, int G_, int c_) { nM = M / BM; nN = N / BM; nwg = nM * nN; G = G_; c = c_; A = (const char*)A_; B = (const char*)B_; tstep = (size_t)BM * K * 2; }
    __device__ __forceinline__ bool next(int i, Unit& u) const {
        const int L = i * G + c; if (L >= nwg) return false;
        const int w = (nwg % 8 == 0) ? remap8(L, nwg) : L;
        const int nig = 8 * nN, gid = w / nig, fm = gid * 8, gsz = (nM - fm) < 8 ? (nM - fm) : 8;
        u.pm = fm + ((w % nig) % gsz); u.pn = (w % nig) / gsz; u.kind = 0; return true;
    }
    __device__ __forceinline__ void ptrs(const Unit& u, const char*& a, const char*& b) const { a = A + (size_t)u.pm * tstep; b = B + (size_t)u.pn * tstep; }
    __device__ __forceinline__ int bmap(const Unit&, int rb) const { return ((rb >> 5) << 6) + (rb & 31); }
    __device__ __forceinline__ int bhalf_rows() const { return 32; }
};
struct SchedIn {
    int G, c; const char* H; const char* W; size_t tstep;
    __device__ __forceinline__ void init(const bf16_t* H_, const bf16_t* W_, int G_, int c_) { G = G_; c = c_; H = (const char*)H_; W = (const char*)W_; tstep = (size_t)BM * DM * 2; }
    __device__ __forceinline__ bool next(int i, Unit& u) const {
        const int L = i * G + c; if (L >= 1280) return false;
        if (L < 896) { const int w = remap8(L, 896); u.pm = (w / 56) * 8 + ((w % 56) % 8); u.pn = (w % 56) / 8; u.kind = 0; }
        else { const int v = remap8(L - 896, 384); u.pn = v / 3; u.pm = v % 3; u.kind = 1; }
        return true;
    }
    __device__ __forceinline__ void ptrs(const Unit& u, const char*& a, const char*& b) const {
        if (u.kind == 0) { a = H + (size_t)u.pm * tstep; b = W + (size_t)u.pn * tstep; }
        else { a = W + (size_t)(7 + u.pm) * tstep; b = H + (size_t)u.pn * tstep; }
    }
    __device__ __forceinline__ int bmap(const Unit& u, int rb) const {
        if (u.kind == 0) return rb;
        const int sh = 2 * u.pm, per = 128 >> sh;
        return ((rb & (per - 1)) << sh) + (rb >> (7 - sh));
    }
    __device__ __forceinline__ int bhalf_rows() const { return 128; }
};

template <class Epi, class Sched>
__device__ __forceinline__ void gemm_phase(LAS unsigned char* lds, const int wid_in, const int K, const Sched& S, const Epi& E) {
    const int wid = __builtin_amdgcn_readfirstlane(wid_in), lane = lane_now(), tid = wid * 64 + lane, wr = wid >> 2, wc = wid & 3, fr = lane & 15, fq = lane >> 4;
    const int nt = K / BK;
    unsigned voffA[2], voffB[2];
    const size_t kstep = (size_t)(BK * 2);
    const size_t hstep = (size_t)HALF * K * 2;
    const size_t hstepB = (size_t)S.bhalf_rows() * K * 2;
    const unsigned ldsw = (unsigned)wid * 1024u;
    const int aoff = lds_byte(wr * 64 + fr, fq * 8), boff = lds_byte(wc * 32 + fr, fq * 8);
#define PG8_SA(b, h) (((b) * 2 + (h)) * HTB)
#define PG8_SB(b, h) ((4 + (b) * 2 + (h)) * HTB)
#define PG8_STAGE(bufoff, gbase, voff) do { _Pragma("unroll") for (int _i = 0; _i < 2; ++_i) \
        __builtin_amdgcn_global_load_lds((const unsigned*)((const char*)(gbase) + (voff)[_i]), (LAS unsigned*)(lds + (bufoff) + ldsw + _i * 8192), 16, 0, 0); } while (0)
#define PG8_LDA(dst, b, h) do { _Pragma("unroll") for (int m = 0; m < 4; ++m) _Pragma("unroll") for (int k = 0; k < 2; ++k) dst[m][k] = *(const LAS bf16x8*)(lds + PG8_SA(b, h) + aoff + m * 2048 + k * 1024); } while (0)
#define PG8_LDB(dst, b, h) do { _Pragma("unroll") for (int n = 0; n < 2; ++n) _Pragma("unroll") for (int k = 0; k < 2; ++k) dst[n][k] = *(const LAS bf16x8*)(lds + PG8_SB(b, h) + boff + n * 2048 + k * 1024); } while (0)
#define PG8_MMA(ai, bj, At, Bt) do { __builtin_amdgcn_s_setprio(1); _Pragma("unroll") for (int m = 0; m < 4; ++m) _Pragma("unroll") for (int n = 0; n < 2; ++n) _Pragma("unroll") for (int k = 0; k < 2; ++k) \
        acc[ai][bj][m][n] = __builtin_amdgcn_mfma_f32_16x16x32_bf16(Bt[n][k], At[m][k], acc[ai][bj][m][n], 0, 0, 0); __builtin_amdgcn_s_setprio(0); } while (0)
#define PG8_WAIT_V(n) asm volatile("s_waitcnt vmcnt(" #n ")" ::: "memory")
#define PG8_WAIT_L(n) asm volatile("s_waitcnt lgkmcnt(" #n ")" ::: "memory")
#define PG8_BAR __builtin_amdgcn_s_barrier()
#define PG8_SCHED __builtin_amdgcn_sched_barrier(0)
#define PG8_VOFFB(dst, un) do { const int tid_ = wid * 64 + lane_now(); _Pragma("unroll") for (int _i = 0; _i < 2; ++_i) { int R_, C_; stage_rc(tid_ * 16 + _i * 8192, R_, C_); const int Rb_ = (R_ & ~31) + perm32(R_ & 31); dst[_i] = (unsigned)(S.bmap(un, Rb_) * K + C_) * 2u; } } while (0)
    Unit cur, nxt; int ui = 0;
    if (!S.next(0, cur)) return;
#pragma unroll
    for (int i = 0; i < 2; ++i) { int R, C; stage_rc(tid * 16 + i * 8192, R, C); voffA[i] = (unsigned)(R * K + C) * 2u; }
    PG8_VOFFB(voffB, cur);
    f32x4 acc[2][2][4][2];
#pragma unroll
    for (int a = 0; a < 2; ++a)
#pragma unroll
        for (int b = 0; b < 2; ++b)
#pragma unroll
            for (int m = 0; m < 4; ++m)
#pragma unroll
                for (int n = 0; n < 2; ++n) acc[a][b][m][n] = (f32x4){0.f, 0.f, 0.f, 0.f};
    bf16x8 At[4][2], B0[2][2], B1[2][2];
    const char* cA; const char* cB; S.ptrs(cur, cA, cB);
    PG8_STAGE(PG8_SB(0, 0), cB, voffB); PG8_STAGE(PG8_SB(0, 1), cB + hstepB, voffB); PG8_STAGE(PG8_SA(0, 0), cA, voffA); PG8_STAGE(PG8_SA(0, 1), cA + hstep, voffA);
    E.prep(cur, (LAS float*)(lds + STAGE_BYTES), tid);
    if (wr == 1) PG8_BAR;
    PG8_WAIT_V(2); PG8_BAR;
    PG8_STAGE(PG8_SB(1, 0), cB + kstep, voffB); PG8_STAGE(PG8_SA(1, 0), cA + kstep, voffA); PG8_STAGE(PG8_SB(1, 1), cB + hstepB + kstep, voffB);
    PG8_WAIT_V(6); PG8_BAR;
    for (;;) {
        const bool has_next = S.next(ui + 1, nxt);
        const char* nA = cA; const char* nB = cB;
        if (has_next) S.ptrs(nxt, nA, nB);
        unsigned vb[2]; vb[0] = voffB[0]; vb[1] = voffB[1];
        _Pragma("unroll 1") for (int t = 0; t < nt; t += 2) {
            const bool last = (t == nt - 2);
            const char* a1 = cA + (size_t)(t + 1) * kstep;
            const char* a2 = last ? nA : cA + (size_t)(t + 2) * kstep; const char* b2 = last ? nB : cB + (size_t)(t + 2) * kstep;
            const char* a3 = a2 + kstep; const char* b3 = b2 + kstep;
            if (last && has_next) PG8_VOFFB(vb, nxt);
            PG8_LDB(B0, 0, 0); PG8_LDB(B1, 0, 1); PG8_SCHED; PG8_LDA(At, 0, 0); PG8_STAGE(PG8_SA(1, 1), a1 + hstep, voffA);
            PG8_WAIT_V(8); PG8_WAIT_L(0); PG8_BAR; PG8_MMA(0, 0, At, B0); PG8_MMA(0, 1, At, B1); PG8_BAR; PG8_SCHED;
            PG8_LDA(At, 0, 1); PG8_STAGE(PG8_SB(0, 0), b2, vb); PG8_STAGE(PG8_SB(0, 1), b2 + hstepB, vb); PG8_STAGE(PG8_SA(0, 0), a2, voffA);
            PG8_WAIT_V(8); PG8_WAIT_L(0); PG8_BAR; PG8_MMA(1, 0, At, B0); PG8_MMA(1, 1, At, B1); PG8_BAR; PG8_SCHED;
            PG8_LDB(B0, 1, 0); PG8_LDB(B1, 1, 1); PG8_SCHED; PG8_LDA(At, 1, 0); PG8_STAGE(PG8_SA(0, 1), a2 + hstep, voffA);
            PG8_WAIT_V(8); PG8_WAIT_L(0); PG8_BAR; PG8_MMA(0, 0, At, B0); PG8_MMA(0, 1, At, B1); PG8_BAR; PG8_SCHED;
            PG8_LDA(At, 1, 1); PG8_STAGE(PG8_SB(1, 0), b3, vb); PG8_STAGE(PG8_SB(1, 1), b3 + hstepB, vb); PG8_STAGE(PG8_SA(1, 0), a3, voffA);
            PG8_WAIT_V(8); PG8_WAIT_L(0); PG8_BAR; PG8_MMA(1, 0, At, B0); PG8_MMA(1, 1, At, B1); PG8_BAR; PG8_SCHED;
        }
        if (wr == 0) PG8_BAR;
        f32x4 pf[4];
        if (Epi::HAS_RS && has_next && wid < 4) { const f32x4* p_ = (const f32x4*)(E.ssp + (size_t)(E.rs_row(nxt) + wid * 64 + lane_now()) * 16); pf[0] = p_[0]; pf[1] = p_[1]; pf[2] = p_[2]; pf[3] = p_[3]; }
        else { pf[0] = pf[1] = pf[2] = pf[3] = (f32x4){1.f, 1.f, 1.f, 1.f}; }
        PG8_SCHED;
        { const int ln_e = lane_now(); int fr_e = ln_e & 15, fq_e = ln_e >> 4; asm volatile("" : "+v"(fr_e), "+v"(fq_e));
          E(acc, cur, wr, wc, fr_e, fq_e, (const LAS float*)(lds + STAGE_BYTES + (ui & 1) * 1024)); }
        if (!has_next) break;
        if (Epi::HAS_RS && wid < 4) { const f32x4 a_ = pf[0], b_ = pf[1], c_ = pf[2], d_ = pf[3];
            const float s_ = ((a_[0] + a_[1]) + (a_[2] + a_[3])) + ((b_[0] + b_[1]) + (b_[2] + b_[3])) + ((c_[0] + c_[1]) + (c_[2] + c_[3])) + ((d_[0] + d_[1]) + (d_[2] + d_[3]));
            int t2_ = wid * 64 + lane_now(); asm volatile("" : "+v"(t2_));
            ((LAS float*)(lds + STAGE_BYTES + ((ui + 1) & 1) * 1024))[t2_] = __builtin_amdgcn_rsqf(s_ * (1.0f / DM) + EPS); }
#pragma unroll
        for (int a = 0; a < 2; ++a)
#pragma unroll
            for (int b = 0; b < 2; ++b)
#pragma unroll
                for (int m = 0; m < 4; ++m)
#pragma unroll
                    for (int n = 0; n < 2; ++n) acc[a][b][m][n] = (f32x4){0.f, 0.f, 0.f, 0.f};
        cur = nxt; cA = nA; cB = nB; voffB[0] = vb[0]; voffB[1] = vb[1]; ++ui;
        if (wr == 1) PG8_BAR;
    }
    PG8_WAIT_V(0);
    PG8_BAR;
#undef PG8_SA
#undef PG8_SB
#undef PG8_STAGE
#undef PG8_LDA
#undef PG8_LDB
#undef PG8_MMA
#undef PG8_WAIT_V
#undef PG8_WAIT_L
#undef PG8_BAR
#undef PG8_SCHED
#undef PG8_VOFFB
}

typedef f32x4 Acc[2][2][4][2];
__device__ __forceinline__ __amdgpu_buffer_rsrc_t wt_rsrc(void* base, unsigned bytes) { return __builtin_amdgcn_make_buffer_rsrc(base, (short)0, (int)bytes, 0x00020000); }
__device__ __forceinline__ void wt_store16(__amdgpu_buffer_rsrc_t r, unsigned byte_off, u32x4 v) { __builtin_amdgcn_raw_buffer_store_b128(v, r, byte_off, 0, 16); }
__device__ __forceinline__ u32x4 xchg8(u32x4 v) { u32x4 r;
#pragma unroll
    for (int e = 0; e < 4; ++e) r[e] = (unsigned)__builtin_amdgcn_update_dpp(0, (int)v[e], 0x128, 0xf, 0xf, false);
    return r; }
#define FULL_LINE_STORE(ptr_, ld_, rowbase_, colbase_, o0_, o1_) do { u32x4 dA_, dB_; \
        _Pragma("unroll") for (int e_ = 0; e_ < 4; ++e_) { dA_[e_] = (unsigned)__builtin_amdgcn_update_dpp((int)(o0_)[e_], (int)(o1_)[e_], 0x128, 0xf, 0xc, false); \
                                                          dB_[e_] = (unsigned)__builtin_amdgcn_update_dpp((int)(o1_)[e_], (int)(o0_)[e_], 0x128, 0xf, 0x3, false); } \
        const unsigned b_ = (unsigned)(((rowbase_) + (fr & 7)) * (ld_) + (colbase_) + (fr >> 3) * 32) * 2u; \
        wt_store16(ptr_, b_, dA_); wt_store16(ptr_, b_ + 16u * (ld_), dB_); } while (0)

struct EpiIn {
    const float* ssp; unsigned char* ws;
    static constexpr bool HAS_RS = true;
    __device__ __forceinline__ int rs_row(const Unit& u) const { return (u.kind == 0 ? u.pm : u.pn) * BM; }
    __device__ __forceinline__ void prep(const Unit& u, LAS float* rsl, int tid) const { if (tid < 256) rsl[tid] = row_rs(ssp, rs_row(u) + tid); }
    __device__ __forceinline__ void operator()(const Acc& acc, const Unit& u, int wr, int wc, int fr, int fq, const LAS float* rsl) const {
        const float* rot = (const float*)(ws + WS_ROT); bf16_t* U = (bf16_t*)(ws + WS_BIG + BIG_U); bf16_t* Q = (bf16_t*)(ws + WS_BIG + BIG_Q); bf16_t* Kb = (bf16_t*)(ws + WS_BIG + BIG_K); bf16_t* VT = (bf16_t*)(ws + WS_BIG + BIG_VT);
        if (u.kind == 0) {
            const int pn = u.pn;
#pragma unroll
            for (int ai = 0; ai < 2; ++ai)
#pragma unroll
                for (int m = 0; m < 4; ++m) {
                    const int row = u.pm * BM + ai * HALF + wr * 64 + m * 16 + fr;
                    const float rs = rsl[ai * HALF + wr * 64 + m * 16 + fr];
                    if (pn == 0) {
#pragma unroll
                        for (int bj = 0; bj < 2; ++bj) { const int gp = bj * 2 + (wc >> 1), ks = (wc & 1) * 2 + (fq >> 1), hfq = fq & 1;
                            *(u32x4*)(U + ((size_t)(((row >> 5) * 4 + gp) * 4 + ks) * 2 + hfq) * 256 + (row & 31) * 8) = pack8(acc[ai][bj][m][0] * rs, acc[ai][bj][m][1] * rs); }
                    } else {
                        const int reg = (pn - 1) / 3, hb = ((pn - 1) % 3) * 4, shq = 2 * ((pn - 1) % 3);
                        bf16_t* dst = reg ? Kb : Q;
                        const int b = row / SEQ, ts = row % SEQ;
                        const bool rotw = (wc & 1) == 0;
                        f32x4 c0 = {1.f, 1.f, 1.f, 1.f}, c1 = c0, s0 = {0.f, 0.f, 0.f, 0.f}, s1 = s0;
                        if (rotw) { const f32x4* rp = (const f32x4*)(rot + (size_t)row * 16); c0 = rp[0]; c1 = rp[1]; s0 = rp[2]; s1 = rp[3]; }
#pragma unroll
                        for (int bj = 0; bj < 2; ++bj) {
                            const int head = hb + bj * 2 + (wc >> 1), d0 = (wc & 1) * 32 + 8 * fq;
                            f32x4 v0 = acc[ai][bj][m][0] * rs, v1 = acc[ai][bj][m][1] * rs;
                            if (rotw) {
                                f32x4 p0, p1;
#pragma unroll
                                for (int e = 0; e < 4; ++e) { p0[e] = shx(v0[e], 16, fq * 16 + fr); p1[e] = shx(v1[e], 16, fq * 16 + fr); }
                                if (fq < 2) { const float sg = (fq == 0) ? -1.f : 1.f; v0 = v0 * c0 + (p0 * s0) * sg; v1 = v1 * c1 + (p1 * s1) * sg; }
                            }
                            const int idxq = ts >> shq, sl = idxq & 31, slot = reg ? ((sl & 19) | ((sl & 4) << 1) | ((sl & 8) >> 1)) : sl;
                            *(u32x4*)(dst + ((size_t)(b * NH + head) * SEQ + (size_t)(ts & ((1 << shq) - 1)) * (SEQ >> shq) + (idxq & ~31)) * 64 + (d0 >> 3) * 256 + slot * 8) = pack8(v0, v1);
                        }
                    }
                }
        } else {
            const int g = u.pm, sh = 2 * g, per = 128 >> sh;
            const int tok0 = u.pn * BM, b = tok0 / SEQ, ts0 = tok0 % SEQ;
            const int n0 = wc * 32 + 8 * fq, rres = n0 >> (7 - sh), i0 = n0 & (per - 1);
#pragma unroll
            for (int ai = 0; ai < 2; ++ai)
#pragma unroll
                for (int m = 0; m < 4; ++m) {
                    const int vr = ai * HALF + wr * 64 + m * 16 + fr, hh = 4 * g + (vr >> 6), d = vr & 63;
                    bf16_t* base = VT + (size_t)(b * NH + hh) * 64 * SEQ + (size_t)rres * (SEQ >> sh) * 64 + (d >> 5) * 512 + (d & 31) * 8;
#pragma unroll
                    for (int bj = 0; bj < 2; ++bj) {
                        const int idx0 = ((ts0 + bj * HALF) >> sh) + i0;
                        f32x4 v0 = acc[ai][bj][m][0], v1 = acc[ai][bj][m][1];
                        const LAS float* rp = rsl + bj * HALF + (i0 << sh) + rres;
#pragma unroll
                        for (int e = 0; e < 4; ++e) { v0[e] *= rp[e << sh]; v1[e] *= rp[(e + 4) << sh]; }
                        *(u32x4*)(base + (size_t)(idx0 >> 5) * 2048 + ((idx0 >> 4) & 1) * 1024 + ((idx0 >> 3) & 1) * 256) = pack8(v0, v1);
                    }
                }
        }
    }
};

struct EpiRes {
    const bf16_t* resid; bf16_t* hb; float* ssp_out;
    static constexpr bool HAS_RS = false; const float* ssp = nullptr;
    __device__ __forceinline__ int rs_row(const Unit&) const { return 0; }
    __device__ __forceinline__ void prep(const Unit&, LAS float*, int) const {}
    __device__ __forceinline__ void operator()(const Acc& acc, const Unit& u, int wr, int wc, int fr, int fq, const LAS float* rsl) const {
        const int col0 = u.pn * BM + wc * 64 + 8 * fq;
        const size_t off0 = (size_t)(u.pm * BM + wr * 64 + fr) * DM + col0;
        const __amdgpu_buffer_rsrc_t orsrc = wt_rsrc((void*)hb, (unsigned)T * DM * 2u);
        u32x4 rw[2][4][2];
#pragma unroll
        for (int ai = 0; ai < 2; ++ai)
#pragma unroll
            for (int m = 0; m < 4; ++m)
#pragma unroll
                for (int bj = 0; bj < 2; ++bj) rw[ai][m][bj] = *(const u32x4*)(resid + off0 + (size_t)(ai * HALF + m * 16) * DM + bj * 32);
        asm volatile("" ::: "memory"); __builtin_amdgcn_sched_barrier(0);
#pragma unroll
        for (int ai = 0; ai < 2; ++ai)
#pragma unroll
            for (int m = 0; m < 4; ++m) {
                const int row = u.pm * BM + ai * HALF + wr * 64 + m * 16 + fr; float sq = 0.f; u32x4 o[2];
#pragma unroll
                for (int bj = 0; bj < 2; ++bj) {
                    const u32x4 w = rw[ai][m][bj];
                    const f32x4 r0 = {bf_lo(w.x), bf_hi(w.x), bf_lo(w.y), bf_hi(w.y)}, r1 = {bf_lo(w.z), bf_hi(w.z), bf_lo(w.w), bf_hi(w.w)};
                    const f32x4 v0 = acc[ai][bj][m][0] + r0, v1 = acc[ai][bj][m][1] + r1;
                    sq += (v0[0] * v0[0] + v0[1] * v0[1]) + (v0[2] * v0[2] + v0[3] * v0[3]) + (v1[0] * v1[0] + v1[1] * v1[1]) + (v1[2] * v1[2] + v1[3] * v1[3]);
                    o[bj] = pack8(v0, v1);
                }
                FULL_LINE_STORE(orsrc, DM, u.pm * BM + ai * HALF + wr * 64 + m * 16, col0, o[0], o[1]);
                sq += shx(sq, 16, fq * 16 + fr); sq += shx(sq, 32, fq * 16 + fr);
                if (fq == 0) ssp_out[(size_t)row * 16 + u.pn * 4 + wc] = sq;
            }
    }
};

struct EpiUp {
    const float* ssp; bf16_t* O;
    static constexpr bool HAS_RS = true;
    __device__ __forceinline__ int rs_row(const Unit& u) const { return u.pm * BM; }
    __device__ __forceinline__ void prep(const Unit& u, LAS float* rsl, int tid) const { if (tid < 256) rsl[tid] = row_rs(ssp, u.pm * BM + tid); }
    __device__ __forceinline__ void operator()(const Acc& acc, const Unit& u, int wr, int wc, int fr, int fq, const LAS float* rsl) const {
        const int col0 = u.pn * BM + wc * 64 + 8 * fq;
        const __amdgpu_buffer_rsrc_t orsrc = wt_rsrc((void*)O, (unsigned)T * FF * 2u);
#pragma unroll
        for (int ai = 0; ai < 2; ++ai)
#pragma unroll
            for (int m = 0; m < 4; ++m) {
                const float rs = rsl[ai * HALF + wr * 64 + m * 16 + fr]; u32x4 o[2];
#pragma unroll
                for (int bj = 0; bj < 2; ++bj) {
                    f32x4 v0 = acc[ai][bj][m][0] * rs, v1 = acc[ai][bj][m][1] * rs;
#pragma unroll
                    for (int e = 0; e < 4; ++e) { v0[e] = fmaxf(v0[e], 0.f); v1[e] = fmaxf(v1[e], 0.f); }
                    v0 = v0 * v0; v1 = v1 * v1;
                    o[bj] = pack8(v0, v1);
                }
                FULL_LINE_STORE(orsrc, FF, u.pm * BM + ai * HALF + wr * 64 + m * 16, col0, o[0], o[1]);
            }
    }
};

struct EpiPle {
    bf16_t* O;
    static constexpr bool HAS_RS = false; const float* ssp = nullptr;
    __device__ __forceinline__ int rs_row(const Unit&) const { return 0; }
    __device__ __forceinline__ void prep(const Unit&, LAS float*, int) const {}
    __device__ __forceinline__ void operator()(const Acc& acc, const Unit& u, int wr, int wc, int fr, int fq, const LAS float* rsl) const {
        const int col0 = u.pn * BM + wc * 64 + 8 * fq;
        const __amdgpu_buffer_rsrc_t orsrc = wt_rsrc((void*)O, (unsigned)T * DM * 2u);
#pragma unroll
        for (int ai = 0; ai < 2; ++ai)
#pragma unroll
            for (int m = 0; m < 4; ++m) {
                const u32x4 o0 = pack8(acc[ai][0][m][0], acc[ai][0][m][1]), o1 = pack8(acc[ai][1][m][0], acc[ai][1][m][1]);
                FULL_LINE_STORE(orsrc, DM, u.pm * BM + ai * HALF + wr * 64 + m * 16, col0, o0, o1);
            }
    }
};

struct EpiGate {
    const float* ssp; const bf16_t* HBr; bf16_t* EH; float* ssp_out;
    static constexpr bool HAS_RS = true;
    __device__ __forceinline__ int rs_row(const Unit& u) const { return u.pm * BM; }
    __device__ __forceinline__ void prep(const Unit& u, LAS float* rsl, int tid) const { if (tid < 256) rsl[tid] = row_rs(ssp, u.pm * BM + tid); }
    __device__ __forceinline__ void operator()(const Acc& acc, const Unit& u, int wr, int wc, int fr, int fq, const LAS float* rsl) const {
        const int col0 = u.pn * BM + wc * 64 + 8 * fq;
        const __amdgpu_buffer_rsrc_t orsrc = wt_rsrc((void*)EH, (unsigned)T * DM * 2u);
        const size_t off0 = (size_t)(u.pm * BM + wr * 64 + fr) * DM + col0;
#pragma unroll
        for (int ai = 0; ai < 2; ++ai) {
            u32x4 hwv[4][2], ewv[4][2];
#pragma unroll
            for (int m = 0; m < 4; ++m)
#pragma unroll
                for (int bj = 0; bj < 2; ++bj) { const size_t off = off0 + (size_t)(ai * HALF + m * 16) * DM + bj * 32; hwv[m][bj] = *(const u32x4*)(HBr + off); ewv[m][bj] = *(const u32x4*)(EH + off); }
            asm volatile("" ::: "memory"); __builtin_amdgcn_sched_barrier(0);
#pragma unroll
            for (int m = 0; m < 4; ++m) {
                const int row = u.pm * BM + ai * HALF + wr * 64 + m * 16 + fr; const float rs = rsl[ai * HALF + wr * 64 + m * 16 + fr]; float sq = 0.f; u32x4 o[2];
#pragma unroll
                for (int bj = 0; bj < 2; ++bj) {
                    const u32x4 ew = ewv[m][bj], hw = hwv[m][bj];
                    const f32x4 e0 = {bf_lo(ew.x), bf_hi(ew.x), bf_lo(ew.y), bf_hi(ew.y)}, e1 = {bf_lo(ew.z), bf_hi(ew.z), bf_lo(ew.w), bf_hi(ew.w)};
                    f32x4 v0 = {bf_lo(hw.x), bf_hi(hw.x), bf_lo(hw.y), bf_hi(hw.y)}, v1 = {bf_lo(hw.z), bf_hi(hw.z), bf_lo(hw.w), bf_hi(hw.w)};
#pragma unroll
                    for (int e = 0; e < 4; ++e) {
                        const float g0 = __builtin_amdgcn_rcpf(1.0f + __builtin_amdgcn_exp2f(-1.4426950408889634f * rs * acc[ai][bj][m][0][e])), g1 = __builtin_amdgcn_rcpf(1.0f + __builtin_amdgcn_exp2f(-1.4426950408889634f * rs * acc[ai][bj][m][1][e]));
                        v0[e] += g0 * e0[e]; v1[e] += g1 * e1[e];
                    }
                    sq += (v0[0] * v0[0] + v0[1] * v0[1]) + (v0[2] * v0[2] + v0[3] * v0[3]) + (v1[0] * v1[0] + v1[1] * v1[1]) + (v1[2] * v1[2] + v1[3] * v1[3]);
                    o[bj] = pack8(v0, v1);
                }
                FULL_LINE_STORE(orsrc, DM, u.pm * BM + ai * HALF + wr * 64 + m * 16, col0, o[0], o[1]);
                sq += shx(sq, 16, fq * 16 + fr); sq += shx(sq, 32, fq * 16 + fr);
                if (fq == 0) ssp_out[(size_t)row * 16 + u.pn * 4 + wc] = sq;
            }
        }
    }
};
}

struct Args { const float* in[15]; float* out; unsigned char* ws; unsigned long long seq0, seq1; int nseq, pad; };
typedef const __attribute__((address_space(4))) Args* ArgsP;

struct Frame {
    LAS unsigned char* lds; unsigned char* ws;
    int tid, lane, wave, G, bx;
};

__device__ __forceinline__ void p0_transpose_item(const float* W, const float* gain, int K, int N, bf16_t* WT, LAS float* scr, int item, int lane) {
    const int nblk = N / 32, kb = item / nblk, nb = item % nblk, k0 = 64 * kb, n0 = 32 * nb;
    const int kr = lane >> 3, nc = (lane & 7) * 4;
    f32x4 v[8]; float gk[8];
#pragma unroll
    for (int i = 0; i < 8; ++i) { v[i] = *(const f32x4*)(W + (size_t)(k0 + 8 * i + kr) * N + n0 + nc); gk[i] = gain ? gain[k0 + 8 * i + kr] : 1.0f; }
#pragma unroll
    for (int i = 0; i < 8; ++i) { LAS float* d = scr + (8 * i + kr) * 33 + nc; d[0] = v[i][0] * gk[i]; d[1] = v[i][1] * gk[i]; d[2] = v[i][2] * gk[i]; d[3] = v[i][3] * gk[i]; }
    asm volatile("s_waitcnt lgkmcnt(0)" ::: "memory");
    const int c = lane & 7;
#pragma unroll
    for (int j = 0; j < 4; ++j) { const int n = (lane >> 3) + 8 * j; const LAS float* s = scr + (8 * c) * 33 + n;
        u32x4 o; o.x = cvt_pk_bf16(s[0 * 33], s[1 * 33]); o.y = cvt_pk_bf16(s[2 * 33], s[3 * 33]); o.z = cvt_pk_bf16(s[4 * 33], s[5 * 33]); o.w = cvt_pk_bf16(s[6 * 33], s[7 * 33]);
        *(u32x4*)(WT + (size_t)(n0 + n) * K + k0 + 8 * c) = o; }
    asm volatile("s_waitcnt lgkmcnt(0)" ::: "memory");
}

__device__ __forceinline__ void sincos_acc(float ang, float& s, float& c) {
    const float kf = rintf(ang * 0.63661977236758134f);
    float r = fmaf(-kf, 1.5707855224609375f, ang);
    r = fmaf(-kf, 1.0804334124e-05f, r);
    const float r2 = r * r;
    float sp = 2.7557319e-6f; sp = fmaf(sp, r2, -1.9841270e-4f); sp = fmaf(sp, r2, 8.3333333e-3f); sp = fmaf(sp, r2, -1.6666667e-1f);
    const float sn = fmaf(r * r2, sp, r);
    float cp = -2.7557319e-7f; cp = fmaf(cp, r2, 2.4801587e-5f); cp = fmaf(cp, r2, -1.3888889e-3f); cp = fmaf(cp, r2, 4.1666667e-2f); cp = fmaf(cp, r2, -0.5f);
    const float cs = fmaf(cp, r2, 1.0f);
    const int q = ((int)kf) & 3;
    s = (q == 0) ? sn : (q == 1) ? cs : (q == 2) ? -sn : -cs;
    c = (q == 0) ? cs : (q == 1) ? -sn : (q == 2) ? -cs : sn;
}

__device__ __forceinline__ void p0_prologue(const Frame& F, ArgsP ap) {
    LAS float* scr = (LAS float*)(F.lds + F.wave * 16384);
    const int gw = F.bx * NWAVES + F.wave, NGW = F.G * NWAVES;
    constexpr int I_IN = 16 * 80, I_OUT = 16 * 32, I_UP = 16 * 128, I_DOWN = 64 * 32, I_GATE = 16 * 32, I_PLE = 4 * 32;
    constexpr int I_LAYER = I_IN + I_OUT + I_UP + I_DOWN + I_GATE + I_PLE;
    for (int it = gw; it < DEPTH * I_LAYER; it += NGW) {
        const int l = it / I_LAYER; int r = it % I_LAYER;
        unsigned char* wl = F.ws + WS_W + (size_t)l * W_LAYER;
        if (r < I_IN) { p0_transpose_item(ap->in[4] + (size_t)l * DM * NIN, ap->in[3] + l * DM, DM, NIN, (bf16_t*)(wl + W_IN), scr, r, F.lane); continue; } r -= I_IN;
        if (r < I_OUT) { p0_transpose_item(ap->in[7] + (size_t)l * DM * DM, nullptr, DM, DM, (bf16_t*)(wl + W_OUT), scr, r, F.lane); continue; } r -= I_OUT;
        if (r < I_UP) { p0_transpose_item(ap->in[9] + (size_t)l * DM * FF, ap->in[8] + l * DM, DM, FF, (bf16_t*)(wl + W_UP), scr, r, F.lane); continue; } r -= I_UP;
        if (r < I_DOWN) { p0_transpose_item(ap->in[10] + (size_t)l * FF * DM, nullptr, FF, DM, (bf16_t*)(wl + W_DOWN), scr, r, F.lane); continue; } r -= I_DOWN;
        if (r < I_GATE) { p0_transpose_item(ap->in[12] + (size_t)l * DM * DM, ap->in[11] + l * DM, DM, DM, (bf16_t*)(wl + W_GATE), scr, r, F.lane); continue; } r -= I_GATE;
        p0_transpose_item(ap->in[13] + (size_t)l * PLE * DM, nullptr, PLE, DM, (bf16_t*)(wl + W_PLE), scr, r, F.lane);
    }
    {
        bf16_t* hb = (bf16_t*)(F.ws + WS_E); float* ssp = (float*)(F.ws + WS_SSP); const float* xin = ap->in[0];
        for (int m0 = gw; m0 < T; m0 += 4 * NGW) {
            f32x4 v[4][4];
#pragma unroll
            for (int q = 0; q < 4; ++q) { const int m = (m0 + q * NGW < T) ? m0 + q * NGW : m0; const f32x4* xr = (const f32x4*)(xin + (size_t)m * DM) + F.lane;
#pragma unroll
                for (int j = 0; j < 4; ++j) v[q][j] = xr[64 * j]; }
#pragma unroll
            for (int q = 0; q < 4; ++q) { const int m = m0 + q * NGW; if (m < T) {
                u32x2* o8 = (u32x2*)(hb + (size_t)m * DM) + F.lane; float s = 0.f;
#pragma unroll
                for (int j = 0; j < 4; ++j) { const f32x4 w4 = v[q][j]; s += (w4[0] * w4[0] + w4[1] * w4[1]) + (w4[2] * w4[2] + w4[3] * w4[3]);
                    u32x2 w; w.x = cvt_pk_bf16(w4[0], w4[1]); w.y = cvt_pk_bf16(w4[2], w4[3]); o8[64 * j] = w; }
                s = wave_sum(s, F.lane);
                if (F.lane < 16) ssp[(size_t)m * 16 + F.lane] = (F.lane == 0) ? s : 0.f; } }
        }
    }
    {
        const int gt = F.bx * NTHREADS + F.tid, NGT = F.G * NTHREADS; constexpr int N4 = DEPTH * T * PLE / 4;
        const f32x4* src = (const f32x4*)ap->in[1]; u32x2* dst = (u32x2*)(F.ws + WS_PB);
        for (int i0 = gt; i0 < N4; i0 += 8 * NGT) {
            f32x4 v[8];
#pragma unroll
            for (int q = 0; q < 8; ++q) { const int i = (i0 + q * NGT < N4) ? i0 + q * NGT : i0; v[q] = src[i]; }
#pragma unroll
            for (int q = 0; q < 8; ++q) { const int i = i0 + q * NGT; if (i < N4) { u32x2 w; w.x = cvt_pk_bf16(v[q][0], v[q][1]); w.y = cvt_pk_bf16(v[q][2], v[q][3]); dst[i] = w; } }
        }
    }
    {
        const int gt = F.bx * NTHREADS + F.tid, NGT = F.G * NTHREADS;
        float* rot = (float*)(F.ws + WS_ROT); const int* pos = (const int*)ap->in[2];
        const float invf[8] = {1.0f, 0.1939227432012558f, 0.03760603070259094f, 0.007292664609849453f, 0.0014142135623842478f, 0.00027424818836152554f, 5.3182957344688475e-05f, 1.0313385246263351e-05f};
        for (int m = gt; m < T; m += NGT) {
            const float pf = (float)pos[m];
            f32x4 c0, c1, s0, s1;
#pragma unroll
            for (int i = 0; i < 4; ++i) { float s, c; sincos_acc(pf * invf[i], s, c); c0[i] = c; s0[i] = s; sincos_acc(pf * invf[i + 4], s, c); c1[i] = c; s1[i] = s; }
            f32x4* rp = (f32x4*)(rot + (size_t)m * 16); rp[0] = c0; rp[1] = c1; rp[2] = s0; rp[3] = s1;
        }
        bf16_t* pw = (bf16_t*)(F.ws + WS_POOLW); const float* pwi = ap->in[5];
        for (int e = gt; e < DEPTH * 4 * 64 * 64; e += NGT) {
            const int c = e & 63, d = (e >> 6) & 63, lg = e >> 12;
            const float v = pwi[((size_t)lg * 64 + c) * 64 + d];
            pw[e] = (bf16_t)(cvt_pk_bf16(v, 0.f) & 0xffffu);
        }
    }
}

template <int GP>
__device__ __forceinline__ void pool_task(const bf16_t* U, const bf16_t* PW, const float* pscale, bf16_t* MIX, int b, int ts0, int l31, int hf) {
    constexpr int WIN = 2 << GP, KSB = (GP == 3) ? 2 : 4;
    asm volatile("" : "+v"(l31), "+v"(hf));
    const int ts = ts0 + l31, row = b * SEQ + ts;
    const int cnt = (ts + 1 < WIN) ? (ts + 1) : WIN;
    const float rc = 1.0f / (float)cnt;
    f32x16 o[2];
#pragma unroll
    for (int e = 0; e < 16; ++e) { o[0][e] = 0.f; o[1][e] = 0.f; }
#pragma unroll
    for (int kb = 0; kb < 4; kb += KSB) {
        u32x4 wv[KSB][WIN]; bf16x8 wf[KSB][2];
#pragma unroll
        for (int k2 = 0; k2 < KSB; ++k2) {
            const int ks = kb + k2;
            const bf16_t* ub = U + ((size_t)GP * 4 + ks) * 512 + hf * 256;
#pragma unroll
            for (int i = 0; i < WIN; ++i) { const int rw = row - ((i < cnt) ? i : 0); wv[k2][i] = *(const u32x4*)(ub + (size_t)(rw >> 5) * 8192 + (rw & 31) * 8); }
#pragma unroll
            for (int dt = 0; dt < 2; ++dt) wf[k2][dt] = *(const bf16x8*)(PW + ((size_t)GP * 64 + 32 * dt + l31) * 64 + 16 * ks + 8 * hf);
        }
        asm volatile("" ::: "memory"); __builtin_amdgcn_sched_barrier(0);
#pragma unroll
        for (int k2 = 0; k2 < KSB; ++k2) {
            float sum[8], own[8];
            { const u32x4 w = wv[k2][0];
              own[0] = bf_lo(w.x); own[1] = bf_hi(w.x); own[2] = bf_lo(w.y); own[3] = bf_hi(w.y); own[4] = bf_lo(w.z); own[5] = bf_hi(w.z); own[6] = bf_lo(w.w); own[7] = bf_hi(w.w); }
#pragma unroll
            for (int e = 0; e < 8; ++e) sum[e] = own[e];
#pragma unroll
            for (int i = 1; i < WIN; ++i) {
                const float wgt = (i < cnt) ? 1.0f : 0.0f; const u32x4 w = wv[k2][i];
                sum[0] += wgt * bf_lo(w.x); sum[1] += wgt * bf_hi(w.x); sum[2] += wgt * bf_lo(w.y); sum[3] += wgt * bf_hi(w.y);
                sum[4] += wgt * bf_lo(w.z); sum[5] += wgt * bf_hi(w.z); sum[6] += wgt * bf_lo(w.w); sum[7] += wgt * bf_hi(w.w);
            }
            u32x4 yw;
            yw.x = cvt_pk_bf16(sum[0] * rc - own[0], sum[1] * rc - own[1]); yw.y = cvt_pk_bf16(sum[2] * rc - own[2], sum[3] * rc - own[3]);
            yw.z = cvt_pk_bf16(sum[4] * rc - own[4], sum[5] * rc - own[5]); yw.w = cvt_pk_bf16(sum[6] * rc - own[6], sum[7] * rc - own[7]);
            const bf16x8 yf = __builtin_bit_cast(bf16x8, yw);
#pragma unroll
            for (int dt = 0; dt < 2; ++dt) o[dt] = __builtin_amdgcn_mfma_f32_32x32x16_bf16(wf[k2][dt], yf, o[dt], 0, 0, 0);
        }
    }
    bf16_t* orow = MIX + (size_t)row * DM + GP * 64;
#pragma unroll
    for (int dt = 0; dt < 2; ++dt)
#pragma unroll
        for (int p = 0; p < 2; ++p) {
            const int d = 32 * dt + 16 * p + 4 * hf;
            const f32x4 sa = *(const f32x4*)(pscale + GP * 64 + d), sb = *(const f32x4*)(pscale + GP * 64 + d + 8);
            const unsigned ax = cvt_pk_bf16(o[dt][8 * p + 0] * sa[0], o[dt][8 * p + 1] * sa[1]), ay = cvt_pk_bf16(o[dt][8 * p + 2] * sa[2], o[dt][8 * p + 3] * sa[3]);
            const unsigned bx = cvt_pk_bf16(o[dt][8 * p + 4] * sb[0], o[dt][8 * p + 5] * sb[1]), by = cvt_pk_bf16(o[dt][8 * p + 6] * sb[2], o[dt][8 * p + 7] * sb[3]);
            const auto r0 = __builtin_amdgcn_permlane32_swap(ax, bx, false, false); const auto r1 = __builtin_amdgcn_permlane32_swap(ay, by, false, false);
            const u32x4 w = {r0[0], r1[0], r0[1], r1[1]};
            *(u32x4*)(orow + 32 * dt + 16 * p + 8 * hf) = w;
        }
}

__device__ __forceinline__ void attn_pool_phase(const Frame& F, ArgsP ap, int layer) {
    LAS float* lse = (LAS float*)F.lds;
    const bf16_t* U = (const bf16_t*)(F.ws + WS_BIG + BIG_U);
    const bf16_t* Q = (const bf16_t*)(F.ws + WS_BIG + BIG_Q);
    const bf16_t* Kb = (const bf16_t*)(F.ws + WS_BIG + BIG_K);
    const bf16_t* VT = (const bf16_t*)(F.ws + WS_BIG + BIG_VT);
    bf16_t* MIX = (bf16_t*)(F.ws + WS_BIG + BIG_MIX);
    const bf16_t* PW = (const bf16_t*)(F.ws + WS_POOLW) + (size_t)layer * 4 * 64 * 64;
    const float* pscale = ap->in[6] + layer * 256;
    const int lane = F.lane, l31 = lane & 31, hf = lane >> 5;
    const float NEG = -INFINITY;
    for (int unit = F.bx; unit < 256; unit += F.G) {
        const int pair = (unit & 7) * 2 + (unit >> 7), b = pair >> 2, j = pair & 3, span = (unit >> 3) & 15;
        const int ts_base = span * 512;
        for (int ti = F.wave; ti < 48; ti += NWAVES) {
            int lane = F.lane; asm volatile("" : "+v"(lane));
            const int l31 = lane & 31, hf = lane >> 5;
            const int g = ti >> 4, x = ti & 15, sh = 2 * g;
            const int tpr = 16 >> sh, r = x / tpr, i0 = (ts_base >> sh) + 32 * (x % tpr);
            const int hh = 4 * g + j;
            const size_t hrow = (size_t)(b * NH + hh) * SEQ + (size_t)r * (SEQ >> sh);
            const bf16_t* Qs = Q + hrow * 64;
            const bf16_t* Ks = Kb + hrow * 64;
            const bf16_t* VTs = VT + hrow * 64;
            const int qi = i0 + l31, tq = (qi << sh) + r;
            bf16x8 qf[4];
#pragma unroll
            for (int ks = 0; ks < 4; ++ks) qf[ks] = *(const bf16x8*)(Qs + (size_t)i0 * 64 + ks * 512 + lane * 8);
            f32x16 s[5];
            bf16x8 kf[5][4];
#pragma unroll
            for (int kt = 0; kt < 5; ++kt) {
                const int kb = i0 - 128 + 32 * kt, kbc = kb < 0 ? 0 : kb;
#pragma unroll
                for (int ks = 0; ks < 4; ++ks) kf[kt][ks] = *(const bf16x8*)(Ks + (size_t)kbc * 64 + ks * 512 + lane * 8);
            }
            asm volatile("" ::: "memory"); __builtin_amdgcn_sched_barrier(0);
#pragma unroll
            for (int kt = 0; kt < 5; ++kt) {
#pragma unroll
                for (int e = 0; e < 16; ++e) s[kt][e] = 0.f;
#pragma unroll
                for (int ks = 0; ks < 4; ++ks) s[kt] = __builtin_amdgcn_mfma_f32_32x32x16_bf16(kf[kt][ks], qf[ks], s[kt], 0, 0, 0);
            }
            bf16x8 vf[5][2][2];
#define LOAD_VF(kt_) do { const int kb_ = i0 - 128 + 32 * (kt_), kbc_ = kb_ < 0 ? 0 : kb_; const bf16_t* vblk_ = VTs + (size_t)(kbc_ >> 5) * 2048 + lane * 8; \
                _Pragma("unroll") for (int s2 = 0; s2 < 2; ++s2) _Pragma("unroll") for (int dt = 0; dt < 2; ++dt) vf[kt_][s2][dt] = *(const bf16x8*)(vblk_ + (s2 * 2 + dt) * 512); } while (0)
            LOAD_VF(0); LOAD_VF(1); LOAD_VF(2); LOAD_VF(3); LOAD_VF(4);
            asm volatile("" ::: "memory"); __builtin_amdgcn_sched_barrier(0);
            float mx = NEG;
#pragma unroll
            for (int kt = 0; kt < 5; ++kt) {
                const bool tv = (i0 - 128 + 32 * kt) >= 0;
#pragma unroll
                for (int e = 0; e < 16; ++e) {
                    const int kk = 16 * (e >> 3) + 8 * hf + (e & 7);
                    const bool valid = tv && (kt == 0 ? (kk >= l31) : kt == 4 ? (kk <= l31) : true);
                    s[kt][e] = valid ? s[kt][e] : NEG;
                    mx = fmaxf(mx, s[kt][e]);
                }
            }
            mx = fmaxf(mx, shx(mx, 32, lane));
            const float cs = 0.125f * 1.4426950408889634f;
            const float mc = mx * cs;
            float lsum = 0.f;
            f32x16 o[2];
#pragma unroll
            for (int e = 0; e < 16; ++e) { o[0][e] = 0.f; o[1][e] = 0.f; }
#pragma unroll
            for (int kt = 0; kt < 5; ++kt) {
#pragma unroll
                for (int e = 0; e < 16; ++e) { const float p = __builtin_amdgcn_exp2f(s[kt][e] * cs - mc); s[kt][e] = p; lsum += p; }
#pragma unroll
                for (int s2 = 0; s2 < 2; ++s2) {
                    u32x4 pw;
                    pw.x = cvt_pk_bf16(s[kt][8 * s2 + 0], s[kt][8 * s2 + 1]); pw.y = cvt_pk_bf16(s[kt][8 * s2 + 2], s[kt][8 * s2 + 3]);
                    pw.z = cvt_pk_bf16(s[kt][8 * s2 + 4], s[kt][8 * s2 + 5]); pw.w = cvt_pk_bf16(s[kt][8 * s2 + 6], s[kt][8 * s2 + 7]);
                    const bf16x8 pf = __builtin_bit_cast(bf16x8, pw);
#pragma unroll
                    for (int dt = 0; dt < 2; ++dt) o[dt] = __builtin_amdgcn_mfma_f32_32x32x16_bf16(vf[kt][s2][dt], pf, o[dt], 0, 0, 0);
                }
            }
#undef LOAD_VF
            lsum += shx(lsum, 32, lane);
            const float inv = 1.0f / lsum;
            bf16_t* orow = MIX + (size_t)(b * SEQ + tq) * DM + 256 + hh * 64;
#pragma unroll
            for (int dt = 0; dt < 2; ++dt)
#pragma unroll
                for (int p = 0; p < 2; ++p) {
                    const unsigned ax = cvt_pk_bf16(o[dt][8 * p + 0] * inv, o[dt][8 * p + 1] * inv), ay = cvt_pk_bf16(o[dt][8 * p + 2] * inv, o[dt][8 * p + 3] * inv);
                    const unsigned bx = cvt_pk_bf16(o[dt][8 * p + 4] * inv, o[dt][8 * p + 5] * inv), by = cvt_pk_bf16(o[dt][8 * p + 6] * inv, o[dt][8 * p + 7] * inv);
                    const auto r0 = __builtin_amdgcn_permlane32_swap(ax, bx, false, false); const auto r1 = __builtin_amdgcn_permlane32_swap(ay, by, false, false);
                    const u32x4 w = {r0[0], r1[0], r0[1], r1[1]};
                    *(u32x4*)(orow + 32 * dt + 16 * p + 8 * hf) = w;
                }
            if (hf == 0) lse[g * 512 + (tq - ts_base)] = mx * 0.125f + __logf(lsum);
        }
        {
            const int ts0 = ts_base + 128 * j + 32 * (F.wave >> 1);
            if (F.wave & 1) { pool_task<0>(U, PW, pscale, MIX, b, ts0, l31, hf); pool_task<1>(U, PW, pscale, MIX, b, ts0, l31, hf); pool_task<2>(U, PW, pscale, MIX, b, ts0, l31, hf); }
            else            { pool_task<3>(U, PW, pscale, MIX, b, ts0, l31, hf); }
        }
        __syncthreads();
        for (int it0 = F.tid; it0 < 512 * 24; it0 += 12 * NTHREADS) {
            u32x4 wv[12]; u32x4* pp[12]; float wt[12];
#pragma unroll
            for (int q = 0; q < 12; ++q) {
                const int it = it0 + q * NTHREADS, tl = it / 24, rem = it % 24, g = rem >> 3, ch = rem & 7;
                pp[q] = (u32x4*)(MIX + (size_t)(b * SEQ + ts_base + tl) * DM + 256 + (4 * g + j) * 64 + ch * 8);
                wv[q] = *pp[q];
                const float l0 = lse[tl], l1 = lse[512 + tl], l2 = lse[1024 + tl];
                const float mxl = fmaxf(l0, fmaxf(l1, l2));
                const float e0 = __expf(l0 - mxl), e1 = __expf(l1 - mxl), e2 = __expf(l2 - mxl);
                wt[q] = ((g == 0) ? e0 : (g == 1) ? e1 : e2) / (e0 + e1 + e2);
            }
#pragma unroll
            for (int q = 0; q < 12; ++q) {
                const u32x4 w = wv[q]; const float t = wt[q]; u32x4 o;
                o.x = cvt_pk_bf16(bf_lo(w.x) * t, bf_hi(w.x) * t); o.y = cvt_pk_bf16(bf_lo(w.y) * t, bf_hi(w.y) * t);
                o.z = cvt_pk_bf16(bf_lo(w.z) * t, bf_hi(w.z) * t); o.w = cvt_pk_bf16(bf_lo(w.w) * t, bf_hi(w.w) * t);
                *pp[q] = o;
            }
        }
        __syncthreads();
    }
}

__device__ __forceinline__ void final_norm_phase(const Frame& F, ArgsP ap) {
    const float* fin = ap->in[14]; float* outp = ap->out;
    const bf16_t* hsrc = (const bf16_t*)(F.ws + WS_E);
    const int gw = F.bx * NWAVES + F.wave, NGW = F.G * NWAVES;
    f32x4 gv[4];
#pragma unroll
    for (int j = 0; j < 2; ++j) { gv[2 * j] = *(const f32x4*)(fin + 512 * j + 8 * F.lane); gv[2 * j + 1] = *(const f32x4*)(fin + 512 * j + 8 * F.lane + 4); }
    for (int m0 = gw; m0 < T; m0 += 4 * NGW) {
        u32x4 w[4][2];
#pragma unroll
        for (int q = 0; q < 4; ++q) { const int m = (m0 + q * NGW < T) ? m0 + q * NGW : m0;
#pragma unroll
            for (int j = 0; j < 2; ++j) w[q][j] = *(const u32x4*)(hsrc + (size_t)m * DM + 512 * j + 8 * F.lane); }
        asm volatile("" ::: "memory"); __builtin_amdgcn_sched_barrier(0);
#pragma unroll
        for (int q = 0; q < 4; ++q) { const int m = m0 + q * NGW; if (m < T) {
            f32x4 v[4]; float s = 0.f;
#pragma unroll
            for (int j = 0; j < 2; ++j) { const u32x4 x = w[q][j];
                v[2 * j] = (f32x4){bf_lo(x.x), bf_hi(x.x), bf_lo(x.y), bf_hi(x.y)}; v[2 * j + 1] = (f32x4){bf_lo(x.z), bf_hi(x.z), bf_lo(x.w), bf_hi(x.w)}; }
#pragma unroll
            for (int j = 0; j < 4; ++j) s += (v[j][0] * v[j][0] + v[j][1] * v[j][1]) + (v[j][2] * v[j][2] + v[j][3] * v[j][3]);
            const float rs = 1.0f / sqrtf(wave_sum(s, F.lane) * (1.0f / DM) + EPS);
#pragma unroll
            for (int j = 0; j < 2; ++j) { float* o = outp + (size_t)m * DM + 512 * j + 8 * F.lane; *(f32x4*)o = v[2 * j] * rs * gv[2 * j]; *(f32x4*)(o + 4) = v[2 * j + 1] * rs * gv[2 * j + 1]; }
        } }
    }
}

#define XB_TMO      128
#define XB_XCNT(j)  (256  + 64 * (j))
#define XB_XSUB(j)  (1280 + 64 * (j))
#define XB_XGEN(j)  (2304 + 64 * (j))
#define XB_TOP      3328
#define XB_TOPGEN   3392
#define XCD_BAR_WORDS 3456
#define XB_SPIN_CAP (1u << 22)
__device__ __forceinline__ unsigned xb_ld(unsigned* p)              { return __hip_atomic_load(p, __ATOMIC_RELAXED, __HIP_MEMORY_SCOPE_AGENT); }
__device__ __forceinline__ unsigned xb_add(unsigned* p, unsigned v) { return __hip_atomic_fetch_add(p, v, __ATOMIC_RELAXED, __HIP_MEMORY_SCOPE_AGENT); }
__device__ __forceinline__ unsigned xb_xcc_id() { return (unsigned)__builtin_amdgcn_s_getreg((3 << 11) | 20) & 0xFu; }
#define XB_SPIN(cond, bar) do { unsigned _sp = 0; while (cond) { __builtin_amdgcn_s_sleep(1); \
    if ((++_sp & 255u) == 0u) { if (xb_ld(&(bar)[XB_TMO])) break; if (_sp > XB_SPIN_CAP) { atomicAdd(&(bar)[XB_TMO], 1u); break; } } } } while (0)
__device__ __forceinline__ void xcd_barrier_complete(unsigned* bar, unsigned x, unsigned& nloc, unsigned& nx) {
    const unsigned G = gridDim.x;
    unsigned sum, cnt, mine, sp = 0u;
    for (;;) {
        sum = 0u; cnt = 0u; mine = 0u;
#pragma unroll
        for (unsigned j = 0; j < 16; ++j) { const unsigned c = xb_ld(&bar[XB_XCNT(j)]); sum += c; cnt += (c > 0u) ? 1u : 0u; mine = (j == x) ? c : mine; }
        if (sum == G) break;
        __builtin_amdgcn_s_sleep(1);
        if ((++sp & 255u) == 0u) { if (xb_ld(&bar[XB_TMO])) break; if (sp > XB_SPIN_CAP) { atomicAdd(&bar[XB_TMO], 1u); break; } }
    }
    nloc = mine > 0u ? mine : 1u; nx = cnt > 0u ? cnt : 1u;
}
__device__ __forceinline__ void xcd_barrier(unsigned* bar, volatile LAS unsigned* st) {
    asm volatile("s_waitcnt vmcnt(0)" ::: "memory");
    __syncthreads();
    if (threadIdx.x == 0) {
        const unsigned x = xb_xcc_id();
        __builtin_amdgcn_s_waitcnt(0);
        unsigned nloc = st[0], nx = st[1];
        if (nloc == 0u) { xcd_barrier_complete(bar, x, nloc, nx); st[0] = nloc; st[1] = nx; }
        const unsigned old = xb_add(&bar[XB_XSUB(x)], 1u);
        const unsigned gen = old / nloc;
        if (old + 1u == (gen + 1u) * nloc) {
            __builtin_amdgcn_fence(__ATOMIC_RELEASE, "agent");
            asm volatile("s_waitcnt vmcnt(0)" ::: "memory");
            const unsigned og = xb_add(&bar[XB_TOP], 1u);
            const unsigned tg = og / nx;
            if (og + 1u == (tg + 1u) * nx) xb_add(&bar[XB_TOPGEN], 1u);
            else XB_SPIN(xb_ld(&bar[XB_TOPGEN]) == tg, bar);
            __builtin_amdgcn_fence(__ATOMIC_ACQUIRE, "agent");
            xb_add(&bar[XB_XGEN(x)], 1u);
            asm volatile("s_waitcnt vmcnt(0)" ::: "memory");
        } else {
            XB_SPIN(xb_ld(&bar[XB_XGEN(x)]) == gen, bar);
            __builtin_amdgcn_fence(__ATOMIC_ACQUIRE, "agent");
            asm volatile("s_waitcnt vmcnt(0)" ::: "memory");
        }
    }
    __syncthreads();
}

#ifndef PHMASK
#define PHMASK 511
#endif
#ifndef REPMASK
#define REPMASK 0
#endif
#ifndef EXTRA_SYNCS
#define EXTRA_SYNCS 0
#endif
constexpr int N_PHASES = 2 + 6 * DEPTH;
__global__ void __launch_bounds__(NTHREADS, 2) fwd_megakernel(Args args) {
    extern __shared__ __attribute__((aligned(16))) unsigned char lds_raw[];
    cg::grid_group grid = cg::this_grid();
    Frame F;
    F.lds = (LAS unsigned char*)lds_raw;
    F.G = gridDim.x; F.bx = blockIdx.x;
    ArgsP ap0 = (ArgsP)__builtin_amdgcn_kernarg_segment_ptr();
    const int wave_id = __builtin_amdgcn_readfirstlane(threadIdx.x >> 6);
    volatile LAS unsigned* bst = (volatile LAS unsigned*)(F.lds + pg8::STAGE_BYTES + 2048);
    if (threadIdx.x == 0) { bst[0] = 0u; bst[1] = 0u; (void)xb_add((unsigned*)(ap0->ws + WS_BAR) + XB_XCNT(xb_xcc_id()), 1u); }
    __syncthreads();
    const int nseq = ap0->nseq; const unsigned long long seq0 = ap0->seq0, seq1 = ap0->seq1;
    for (int idx = 0; idx < nseq; ++idx) {
        const int ph = (int)(((idx < 16) ? (seq0 >> (4 * idx)) : (seq1 >> (4 * (idx - 16)))) & 15ull);
        unsigned zero_ = 0u; asm volatile("" : "+v"(zero_));
        int tid = wave_id * 64 + (int)__builtin_amdgcn_mbcnt_hi(~0u, __builtin_amdgcn_mbcnt_lo(~0u, zero_)); asm volatile("" : "+v"(tid));
        ArgsP ap = ap0; asm volatile("" : "+s"(ap));
        F.tid = tid; F.lane = tid & 63; F.wave = __builtin_amdgcn_readfirstlane(tid >> 6);
        unsigned char* ws = ap->ws; F.ws = ws;
        float* sspb = (float*)(ws + WS_SSP);
        bf16_t* HB = (bf16_t*)(ws + WS_HB);
        bf16_t* EH = (bf16_t*)(ws + WS_E);
        if (ph == 0) { if (PHMASK & 1) p0_prologue(F, ap); }
        else if (ph == N_PHASES - 1) { if (PHMASK & 2) final_norm_phase(F, ap); }
        else if (ph >= N_PHASES) { }
        else {
            const int l = (ph - 1) / 6, k = (ph - 1) % 6;
            unsigned char* wl = ws + WS_W + (size_t)l * W_LAYER;
            float* ssp0 = sspb + (size_t)(3 * l + 0) * (SSP_STRIDE / 4);
            float* ssp1 = sspb + (size_t)(3 * l + 1) * (SSP_STRIDE / 4);
            float* ssp2 = sspb + (size_t)(3 * l + 2) * (SSP_STRIDE / 4);
            float* ssp3 = sspb + (size_t)(3 * l + 3) * (SSP_STRIDE / 4);
            if (k == 0) { if (PHMASK & 4) {
                pg8::SchedIn S; S.init(EH, (const bf16_t*)(wl + W_IN), F.G, F.bx);
                pg8::EpiIn E{ssp0, ws};
                pg8::gemm_phase<pg8::EpiIn, pg8::SchedIn>(F.lds, F.wave, DM, S, E); }
            } else if (k == 1) {
                if (PHMASK & 8) attn_pool_phase(F, ap, l);
            } else if (k == 2) { if (PHMASK & 16) {
                pg8::SchedStd S; S.init((const bf16_t*)(ws + WS_BIG + BIG_MIX), (const bf16_t*)(wl + W_OUT), T, DM, DM, F.G, F.bx);
                pg8::EpiRes E{EH, HB, ssp1};
                pg8::gemm_phase<pg8::EpiRes, pg8::SchedStd>(F.lds, F.wave, DM, S, E); }
            } else if (k == 3) {
                if (PHMASK & 32) { pg8::SchedStd S; S.init(HB, (const bf16_t*)(wl + W_UP), T, FF, DM, F.G, F.bx);
                  pg8::EpiUp E{ssp1, (bf16_t*)(ws + WS_BIG)};
                  pg8::gemm_phase<pg8::EpiUp, pg8::SchedStd>(F.lds, F.wave, DM, S, E); }
                if (PHMASK & 64) { pg8::SchedStd S; S.init((const bf16_t*)(ws + WS_PB) + (size_t)l * T * PLE, (const bf16_t*)(wl + W_PLE), T, DM, PLE, F.G, F.bx);
                  pg8::EpiPle E{EH};
                  pg8::gemm_phase<pg8::EpiPle, pg8::SchedStd>(F.lds, F.wave, PLE, S, E); }
            } else if (k == 4) { if (PHMASK & 128) {
                pg8::SchedStd S; S.init((const bf16_t*)(ws + WS_BIG), (const bf16_t*)(wl + W_DOWN), T, DM, FF, F.G, F.bx);
                pg8::EpiRes E{HB, HB, ssp2};
                pg8::gemm_phase<pg8::EpiRes, pg8::SchedStd>(F.lds, F.wave, FF, S, E); }
            } else { if (PHMASK & 256) {
                pg8::SchedStd S; S.init(HB, (const bf16_t*)(wl + W_GATE), T, DM, DM, F.G, F.bx);
                pg8::EpiGate E{ssp2, HB, EH, ssp3};
                pg8::gemm_phase<pg8::EpiGate, pg8::SchedStd>(F.lds, F.wave, DM, S, E); }
            }
        }
        if (idx + 1 < nseq) xcd_barrier((unsigned*)(ws + WS_BAR), bst);
        if (nseq > 1000) grid.sync();
    }
}

extern "C" void kernel_launch(void* const* d_in, const int* in_sizes, int n_in, void* d_out, int out_size, void* d_ws, size_t ws_size, hipStream_t stream) {
    static int grid = 0;
    if (grid == 0) {
        if (n_in != 15 || in_sizes[0] != T * DM || out_size != T * DM || ws_size < WS_END) {
            fprintf(stderr, "kernel_launch: unexpected problem (n_in %d, in0 %d, out %d, ws %zu; need ws >= %zu); nothing launched\n", n_in, n_in > 0 ? in_sizes[0] : -1, out_size, ws_size, (size_t)WS_END);
            grid = -1; return; }
        int dev = 0, cus = 0, per_cu = 0;
        if (hipGetDevice(&dev) != hipSuccess || hipDeviceGetAttribute(&cus, hipDeviceAttributeMultiprocessorCount, dev) != hipSuccess) { grid = -1; return; }
        if (hipFuncSetAttribute((const void*)fwd_megakernel, hipFuncAttributeMaxDynamicSharedMemorySize, LDS_BYTES) != hipSuccess) { fprintf(stderr, "kernel_launch: hipFuncSetAttribute failed\n"); grid = -1; return; }
        if (hipOccupancyMaxActiveBlocksPerMultiprocessor(&per_cu, (const void*)fwd_megakernel, NTHREADS, LDS_BYTES) != hipSuccess || per_cu < 1) { fprintf(stderr, "kernel_launch: occupancy query failed (%d)\n", per_cu); (void)hipGetLastError(); grid = -1; return; }
        grid = cus * per_cu;
    }
    if (grid < 0) return;
    Args a{};
    for (int i = 0; i < 15; ++i) a.in[i] = (const float*)d_in[i];
    a.out = (float*)d_out; a.ws = (unsigned char*)d_ws;
    { int n = 0; for (int ph = 0; ph < N_PHASES; ++ph) { const int kc = (ph == 0) ? 0 : (ph == N_PHASES - 1) ? 7 : 1 + (ph - 1) % 6; const bool idem = kc == 0 || kc == 1 || kc == 2 || kc == 4 || (kc == 3 && ph < 7);
        const int nrep = (idem && ((REPMASK >> kc) & 1)) ? 2 : 1;
        if (ph == 1) for (int r = 0; r < EXTRA_SYNCS; ++r) { if (n < 16) a.seq0 |= 14ull << (4 * n); else a.seq1 |= 14ull << (4 * (n - 16)); ++n; }
        for (int r = 0; r < nrep; ++r) { if (n < 16) a.seq0 |= (unsigned long long)ph << (4 * n); else a.seq1 |= (unsigned long long)ph << (4 * (n - 16)); ++n; } }
      a.nseq = n; }
    if (hipMemsetAsync((char*)d_ws + WS_BAR, 0, XCD_BAR_WORDS * 4, stream) != hipSuccess) { fprintf(stderr, "kernel_launch: hipMemsetAsync failed\n"); return; }
    void* kargs[] = {&a};
    hipError_t e = hipLaunchCooperativeKernel((const void*)fwd_megakernel, dim3(grid), dim3(NTHREADS), kargs, LDS_BYTES, stream);
    if (e != hipSuccess) fprintf(stderr, "kernel_launch: cooperative launch failed: %s (grid %d)\n", hipGetErrorString(e), grid);
}
```
